# Optimizing an MI355X kernel written in HIP

```python
import math
import jax, jax.numpy as jnp
from jax import lax
import numpy as np

D_MODEL = 1024
BATCH = 8
SEQ = 4096
DEPTH = 2

DA_HEADS = 4
DA_HEAD_DIM = 64
HG_HEADS = 4
HG_DK = 128
HG_DV = 128
HG_CHUNK = 64
LRU_WIDTH = 512
LRU_BLOCKS = 8
CONV_WIDTH = 4
LRU_C = 8.0
SB_HEADS = 8
SB_HEAD_DIM = 64
Q_BLOCK = 128
N_EXPERTS = 16
N_GROUPS = 4
E_PER_GROUP = N_EXPERTS // N_GROUPS
TOP_K = 2
D_FF = 512

DA_QK = DA_HEADS * 2 * DA_HEAD_DIM
DA_V = DA_HEADS * 2 * DA_HEAD_DIM
HG_W = HG_HEADS * HG_DK
HG_VW = HG_HEADS * HG_DV
EVEN_SPLITS = [DA_QK, DA_QK, DA_V, HG_W, HG_W, HG_VW, HG_VW]
EVEN_IN = sum(EVEN_SPLITS)
EVEN_OUT = DA_V + HG_VW
SB_W = SB_HEADS * SB_HEAD_DIM
ODD_SPLITS = [LRU_WIDTH, LRU_WIDTH, SB_W, SB_W, SB_W]
ODD_IN = sum(ODD_SPLITS)
ODD_OUT = LRU_WIDTH + SB_W
DEEPNORM_ALPHA = (2.0 * DEPTH) ** 0.25
DEEPNORM_BETA = (8.0 * DEPTH) ** -0.25

kernel_name = "hybrid_diffattn_hgrn2_rglru_stickbreak_grouped_moe"


def _split_idx(widths):
    return [int(v) for v in np.cumsum(widths)[:-1]]


def layer_norm(x, g, b, eps=1e-5):
    xf = x.astype(jnp.float32)
    mu = jnp.mean(xf, axis=-1, keepdims=True)
    var = jnp.mean(jnp.square(xf - mu), axis=-1, keepdims=True)
    return ((xf - mu) * lax.rsqrt(var + eps)).astype(x.dtype) * g + b


def rms_norm(x, g, eps=1e-6):
    xf = x.astype(jnp.float32)
    return (xf * lax.rsqrt(jnp.mean(xf * xf, axis=-1, keepdims=True) + eps)).astype(x.dtype) * g


def diff_attention(q, k, v, lam, gain, lam_init):
    B, H, T, _, dh = q.shape
    nb = T // Q_BLOCK
    scale = dh ** -0.5
    slopes = 2.0 ** (-8.0 * jnp.arange(1, H + 1, dtype=jnp.float32) / H)
    kpos = jnp.arange(T)
    qb = q.reshape(B, H, nb, Q_BLOCK, 2, dh).transpose(2, 0, 1, 3, 4, 5)
    starts = jnp.arange(nb) * Q_BLOCK

    def block(args):
        qi, start = args
        s = jnp.einsum('bhqcd,bhkcd->bhcqk', qi, k).astype(jnp.float32) * scale
        dist = ((start + jnp.arange(Q_BLOCK))[:, None] - kpos[None, :]).astype(jnp.float32)
        s = s - slopes[None, :, None, None, None] * dist[None, None, None]
        s = jnp.where((dist >= 0)[None, None, None], s, -jnp.inf)
        p = jax.nn.softmax(s, axis=-1)
        a = p[:, :, 0] - lam * p[:, :, 1]
        return jnp.einsum('bhqk,bhkv->bhqv', a.astype(v.dtype), v)

    o = lax.map(block, (qb, starts))
    o = o.transpose(1, 0, 3, 2, 4).reshape(B, T, H, 2 * dh)
    return rms_norm(o, gain) * (1.0 - lam_init)


def hgrn2_chunked(q, log_f, k, v):
    B, H, T, dk = q.shape
    dv = v.shape[-1]
    n = T // HG_CHUNK
    q = q.reshape(B, H, n, HG_CHUNK, dk)
    log_f = log_f.reshape(B, H, n, HG_CHUNK, dk)
    k = k.reshape(B, H, n, HG_CHUNK, dk)
    v = v.reshape(B, H, n, HG_CHUNK, dv)
    b = jnp.cumsum(log_f, axis=3)
    b_mid = b[:, :, :, HG_CHUNK // 2 - 1:HG_CHUNK // 2]
    b_last = b[:, :, :, -1:]
    causal = jnp.tril(jnp.ones((HG_CHUNK, HG_CHUNK), dtype=bool))
    att = jnp.einsum('bhncd,bhnsd->bhncs', q * jnp.exp(b - b_mid), k * jnp.exp(b_mid - b))
    att = jnp.where(causal, att, 0.0)
    o_intra = jnp.einsum('bhncs,bhnsv->bhncv', att, v)
    dS = jnp.einsum('bhncd,bhncv->bhndv', k * jnp.exp(b_last - b), v)
    decay = jnp.exp(b_last[:, :, :, 0])

    def step(S, inp):
        d, ds = inp
        return d[..., None] * S + ds, S

    S0 = jnp.zeros((B, H, dk, dv), dS.dtype)
    _, S_prev = lax.scan(step, S0, (jnp.moveaxis(decay, 2, 0), jnp.moveaxis(dS, 2, 0)))
    S_prev = jnp.moveaxis(S_prev, 0, 2)
    o_inter = jnp.einsum('bhncd,bhndv->bhncv', q * jnp.exp(b), S_prev)
    return (o_intra + o_inter).reshape(B, H, T, dv)


def causal_depthwise_conv(x, w, b):
    C = x.shape[-1]
    W = w.shape[0]
    y = lax.conv_general_dilated(x, w[:, None, :].astype(x.dtype), window_strides=(1,),
                                 padding=[(W - 1, 0)], dimension_numbers=('NWC', 'WIO', 'NWC'),
                                 feature_group_count=C)
    return y + b


def rg_lru(x, w_a, b_a, w_x, b_x, lam):
    B, T, C = x.shape
    xf = x.astype(jnp.float32)
    xb = xf.reshape(B, T, LRU_BLOCKS, C // LRU_BLOCKS)
    r = jax.nn.sigmoid(jnp.einsum('btgi,gij->btgj', xb, w_a).reshape(B, T, C) + b_a)
    i = jax.nn.sigmoid(jnp.einsum('btgi,gij->btgj', xb, w_x).reshape(B, T, C) + b_x)
    log_a = -LRU_C * r * jax.nn.softplus(-lam.astype(jnp.float32))
    a = jnp.exp(log_a)
    u = jnp.sqrt(jnp.maximum(-jnp.expm1(2.0 * log_a), 1e-12)) * (i * xf)

    def combine(e, l):
        a1, h1 = e
        a2, h2 = l
        return a1 * a2, a2 * h1 + h2

    _, h = lax.associative_scan(combine, (a, u), axis=1)
    return h.astype(x.dtype)


def stick_breaking_attention(q, k, v):
    B, H, T, d = q.shape
    nb = T // Q_BLOCK
    kpos = jnp.arange(T)
    qb = q.reshape(B, H, nb, Q_BLOCK, d).transpose(2, 0, 1, 3, 4)
    starts = jnp.arange(nb) * Q_BLOCK
    scale = d ** -0.5

    def block(args):
        qi, start = args
        z = jnp.einsum('bhqd,bhkd->bhqk', qi, k).astype(jnp.float32) * scale
        strict = (kpos[None, :] < (start + jnp.arange(Q_BLOCK))[:, None])[None, None]
        log_1m = jnp.where(strict, jax.nn.log_sigmoid(-z), 0.0)
        after = lax.cumsum(log_1m, axis=3, reverse=True) - log_1m
        a = jnp.where(strict, jnp.exp(jax.nn.log_sigmoid(z) + after), 0.0)
        return jnp.einsum('bhqk,bhkd->bhqd', a.astype(v.dtype), v)

    o = lax.map(block, (qb, starts))
    return o.transpose(1, 0, 3, 2, 4).reshape(B, T, H * d)


def even_mixer(h, w_in, w_out, lam_vecs, diff_gain, hg_gain, lb, lam_init):
    B, T, _ = h.shape
    proj = h @ w_in
    qa, ka, va, qh, fh, ih, gh = jnp.split(proj, _split_idx(EVEN_SPLITS), axis=-1)
    qa = qa.reshape(B, T, DA_HEADS, 2, DA_HEAD_DIM).transpose(0, 2, 1, 3, 4)
    ka = ka.reshape(B, T, DA_HEADS, 2, DA_HEAD_DIM).transpose(0, 2, 1, 3, 4)
    va = va.reshape(B, T, DA_HEADS, 2 * DA_HEAD_DIM).transpose(0, 2, 1, 3)
    lv = lam_vecs.astype(jnp.float32)
    lam = jnp.exp(jnp.sum(lv[0] * lv[1])) - jnp.exp(jnp.sum(lv[2] * lv[3])) + lam_init
    oa = diff_attention(qa, ka, va, lam, diff_gain, lam_init).reshape(B, T, DA_V)
    fl = fh.astype(jnp.float32)
    f = lb + (1.0 - lb) * jax.nn.sigmoid(fl)
    kh = (1.0 - lb) * jax.nn.sigmoid(-fl)
    heads = lambda t: t.reshape(B, T, HG_HEADS, -1).transpose(0, 2, 1, 3)
    ob = hgrn2_chunked(heads(jax.nn.silu(qh.astype(jnp.float32))), heads(jnp.log(f)), heads(kh),
                       heads(ih.astype(jnp.float32)))
    ob = ob.transpose(0, 2, 1, 3).astype(h.dtype)
    ob = rms_norm(ob, hg_gain) * jax.nn.silu(gh.reshape(B, T, HG_HEADS, HG_DV))
    return jnp.concatenate([oa, ob.reshape(B, T, HG_VW)], axis=-1) @ w_out


def odd_mixer(h, w_in, w_out, conv_w, conv_b, w_a, b_a, w_x, b_x, lam):
    B, T, _ = h.shape
    proj = h @ w_in
    xr, gr, qs, ks, vs = jnp.split(proj, _split_idx(ODD_SPLITS), axis=-1)
    xr = causal_depthwise_conv(xr, conv_w, conv_b)
    yr = jax.nn.gelu(gr) * rg_lru(xr, w_a, b_a, w_x, b_x, lam)
    heads = lambda t: t.reshape(B, T, SB_HEADS, SB_HEAD_DIM).transpose(0, 2, 1, 3)
    ys = stick_breaking_attention(heads(qs), heads(ks), heads(vs))
    return jnp.concatenate([yr, ys], axis=-1) @ w_out


def grouped_moe(h, router_w, router_b, w_gate, w_up, w_down):
    B, T, D = h.shape
    xt = h.reshape(B * T, D)
    logits = (xt @ router_w).astype(jnp.float32) + router_b
    probs = jax.nn.softmax(logits, axis=-1)
    pg = probs.reshape(-1, N_GROUPS, E_PER_GROUP)
    group_score = jnp.sum(lax.top_k(pg, TOP_K)[0], axis=-1)
    g_sel = jnp.argmax(group_score, axis=-1)
    in_group = jax.nn.one_hot(g_sel, N_GROUPS, dtype=jnp.float32)[:, :, None] > 0
    masked = jnp.where(in_group, pg, -1.0).reshape(-1, N_EXPERTS)
    top_p, top_i = lax.top_k(masked, TOP_K)
    weights = top_p / jnp.sum(top_p, axis=-1, keepdims=True)
    gates = jnp.sum(jax.nn.one_hot(top_i, N_EXPERTS, dtype=jnp.float32) * weights[..., None], axis=1)
    y = jnp.zeros_like(xt)
    for e in range(N_EXPERTS):
        he = jax.nn.silu(xt @ w_gate[e]) * (xt @ w_up[e])
        y = y + gates[:, e:e + 1].astype(xt.dtype) * (he @ w_down[e])
    return y.reshape(B, T, D)


def setup_inputs(seed: int = 0) -> dict:
    key = jax.random.key(seed)
    ks = jax.random.split(key, 32)
    n_even = (DEPTH + 1) // 2
    n_odd = DEPTH // 2
    nrm = lambda k, shape, s: jax.random.normal(k, shape, jnp.float32) * s
    gb = LRU_WIDTH // LRU_BLOCKS
    u = jax.random.uniform(ks[20], (n_odd, LRU_WIDTH), jnp.float32, 0.9, 0.999)
    s = u ** (1.0 / LRU_C)
    lru_lambda = jnp.log(s) - jnp.log1p(-s)
    return {
        "x": nrm(ks[0], (BATCH, SEQ, D_MODEL), 1.0),
        "c": nrm(ks[1], (BATCH, D_MODEL), 1.0),
        "ada_w": nrm(ks[2], (DEPTH, D_MODEL, 6 * D_MODEL), 0.1 * D_MODEL ** -0.5),
        "ada_b": nrm(ks[3], (DEPTH, 6 * D_MODEL), 0.01),
        "ln_g": 1.0 + nrm(ks[4], (DEPTH, 2, D_MODEL), 0.02),
        "ln_b": nrm(ks[5], (DEPTH, 2, D_MODEL), 0.02),
        "even_w_in": nrm(ks[6], (n_even, D_MODEL, EVEN_IN), D_MODEL ** -0.5),
        "even_w_out": nrm(ks[7], (n_even, EVEN_OUT, D_MODEL), DEEPNORM_BETA * EVEN_OUT ** -0.5),
        "diff_lambda": nrm(ks[8], (n_even, 4, DA_HEAD_DIM), 0.1),
        "diff_gain": 1.0 + nrm(ks[9], (n_even, 2 * DA_HEAD_DIM), 0.02),
        "hgrn_gamma": nrm(ks[10], (DEPTH + 1, HG_W), 0.1),
        "hgrn_gain": 1.0 + nrm(ks[11], (n_even, HG_DV), 0.02),
        "odd_w_in": nrm(ks[12], (n_odd, D_MODEL, ODD_IN), D_MODEL ** -0.5),
        "odd_w_out": nrm(ks[13], (n_odd, ODD_OUT, D_MODEL), DEEPNORM_BETA * ODD_OUT ** -0.5),
        "conv_w": nrm(ks[14], (n_odd, CONV_WIDTH, LRU_WIDTH), CONV_WIDTH ** -0.5),
        "conv_b": nrm(ks[15], (n_odd, LRU_WIDTH), 0.01),
        "lru_wa": nrm(ks[16], (n_odd, LRU_BLOCKS, gb, gb), gb ** -0.5),
        "lru_ba": nrm(ks[17], (n_odd, LRU_WIDTH), 0.01),
        "lru_wx": nrm(ks[18], (n_odd, LRU_BLOCKS, gb, gb), gb ** -0.5),
        "lru_bx": nrm(ks[19], (n_odd, LRU_WIDTH), 0.01),
        "lru_lambda": lru_lambda,
        "router_w": nrm(ks[21], (D_MODEL, N_EXPERTS), D_MODEL ** -0.5),
        "router_b": nrm(ks[22], (N_EXPERTS,), 0.01),
        "moe_w_gate": nrm(ks[23], (DEPTH, N_EXPERTS, D_MODEL, D_FF), D_MODEL ** -0.5),
        "moe_w_up": nrm(ks[24], (DEPTH, N_EXPERTS, D_MODEL, D_FF), D_MODEL ** -0.5),
        "moe_w_down": nrm(ks[25], (DEPTH, N_EXPERTS, D_FF, D_MODEL), DEEPNORM_BETA * D_FF ** -0.5),
    }


def reference(x, c, ada_w, ada_b, ln_g, ln_b, even_w_in, even_w_out, diff_lambda, diff_gain,
              hgrn_gamma, hgrn_gain, odd_w_in, odd_w_out, conv_w, conv_b, lru_wa, lru_ba, lru_wx,
              lru_bx, lru_lambda, router_w, router_b, moe_w_gate, moe_w_up, moe_w_down):
    lower_bounds = jnp.cumsum(jax.nn.softmax(hgrn_gamma.astype(jnp.float32), axis=0), axis=0)
    cond = jax.nn.silu(c)
    for l in range(DEPTH):
        mod = (cond @ ada_w[l] + ada_b[l])[:, None, :]
        sh1, sc1, g1, sh2, sc2, g2 = jnp.split(mod, 6, axis=-1)
        h = x * (1.0 + sc1) + sh1
        if l % 2 == 0:
            j = l // 2
            lam_init = 0.8 - 0.6 * math.exp(-0.3 * l)
            y = even_mixer(h, even_w_in[j], even_w_out[j], diff_lambda[j], diff_gain[j],
                           hgrn_gain[j], lower_bounds[l], lam_init)
        else:
            j = l // 2
            y = odd_mixer(h, odd_w_in[j], odd_w_out[j], conv_w[j], conv_b[j], lru_wa[j], lru_ba[j],
                          lru_wx[j], lru_bx[j], lru_lambda[j])
        x = layer_norm(DEEPNORM_ALPHA * x + (1.0 + g1) * y, ln_g[l, 0], ln_b[l, 0])
        h = x * (1.0 + sc2) + sh2
        y = grouped_moe(h, router_w, router_b, moe_w_gate[l], moe_w_up[l], moe_w_down[l])
        x = layer_norm(DEEPNORM_ALPHA * x + (1.0 + g2) * y, ln_g[l, 1], ln_b[l, 1])
    return x
```

```cpp
#include <hip/hip_runtime.h>
#include <cstdio>
#include <cstdint>

#define GAS __attribute__((address_space(1)))
#define LAS __attribute__((address_space(3)))
typedef unsigned short bf16_t;
typedef short bf16x8 __attribute__((ext_vector_type(8)));
typedef float f32x4 __attribute__((ext_vector_type(4)));
typedef float f32x16 __attribute__((ext_vector_type(16)));
typedef unsigned u32x4 __attribute__((ext_vector_type(4)));
typedef unsigned u32x2 __attribute__((ext_vector_type(2)));

constexpr int B_ = 8, T_ = 4096, D_ = 1024, M_ = B_ * T_;
constexpr int P0 = 3584, P1 = 2560;
constexpr int NE = 16;
constexpr float LOG2E = 1.4426950408889634f, LN2F = 0.6931471805599453f;
constexpr float ALPHA = 1.4142135623730951f;
constexpr float QSC = 0.125f * 1.4426950408889634f;
constexpr float LN_EPS = 1e-5f, RMS_EPS = 1e-6f;
constexpr float LAM_INIT0 = 0.2f;

constexpr size_t MiB = 1u << 20;
constexpr size_t WS_CTL = 0, CTL_BYTES = 1 * MiB;
constexpr size_t WS_MOD = 1 * MiB;
constexpr size_t WS_TOK = 2 * MiB;
constexpr size_t WS_LIST = 3 * MiB;
constexpr size_t WS_LRU = 5 * MiB;
constexpr size_t WS_HGD = 6 * MiB;
constexpr size_t WS_HGS = 8 * MiB;
constexpr size_t WS_WINE = 24 * MiB, WS_WOUTE = 31 * MiB, WS_WINO = 33 * MiB, WS_WOUTO = 38 * MiB;
constexpr size_t WS_GU = 40 * MiB;
constexpr size_t WS_DN = 104 * MiB;
constexpr size_t WS_H = 136 * MiB;
constexpr size_t WS_P = 200 * MiB;
constexpr size_t WS_YS = WS_P + 68 * MiB;
constexpr size_t WS_END = 424 * MiB;
constexpr int CW_GCNT = 64;
constexpr int CW_BAR = 4096;

#ifndef OPT_GEMM
#define OPT_GEMM 1
#endif
#ifndef OPT_SB
#define OPT_SB 1
#endif
#ifndef OPT_HG
#define OPT_HG 1
#endif
#ifndef SINGLE_LAUNCH
#define SINGLE_LAUNCH 1
#endif
#ifndef OPT_LRU
#define OPT_LRU 1
#endif
#ifndef OPT_DA
#define OPT_DA 1
#endif
#ifndef OPT_MOE
#define OPT_MOE 1
#endif
struct TokInfo { int ep1, ep2; float w1, w2; };

__device__ __forceinline__ float bf2f(bf16_t v) { return __uint_as_float((unsigned)v << 16); }
typedef float f32x2_t __attribute__((ext_vector_type(2))); typedef __bf16 bf16x2_t __attribute__((ext_vector_type(2)));
__device__ __forceinline__ unsigned cvt_pk_bf16(float lo, float hi) { f32x2_t v = {lo, hi}; bf16x2_t b = __builtin_convertvector(v, bf16x2_t); return __builtin_bit_cast(unsigned, b); }
__device__ __forceinline__ bf16_t f2bf(float f) { return (bf16_t)(cvt_pk_bf16(f, 0.f) & 0xffffu); }
__device__ __forceinline__ float fexp2(float x) { return __builtin_amdgcn_exp2f(x); }
__device__ __forceinline__ float fexp(float x) { return __builtin_amdgcn_exp2f(x * LOG2E); }
__device__ __forceinline__ float frcp(float x) { return __builtin_amdgcn_rcpf(x); }
__device__ __forceinline__ float sigmoidf_(float x) { return frcp(1.f + fexp(-x)); }
__device__ __forceinline__ float siluf_(float x) { return x * sigmoidf_(x); }
__device__ __forceinline__ float gelu_t(float x) { const float u = 0.7978845608028654f * (x + 0.044715f * x * x * x); const float t = fexp(2.f * u); return 0.5f * x * (2.f - 2.f * frcp(t + 1.f)); }
__device__ __forceinline__ float softplusf_(float x) { return fmaxf(x, 0.f) + log1pf(expf(-fabsf(x))); }
__device__ __forceinline__ float wave_sum(float v) {
#pragma unroll
    for (int o = 1; o < 64; o <<= 1) v += __shfl_xor(v, o);
    return v;
}
__device__ __forceinline__ float wave_max(float v) {
#pragma unroll
    for (int o = 1; o < 64; o <<= 1) v = fmaxf(v, __shfl_xor(v, o));
    return v;
}
__device__ __forceinline__ float act_mode(float v, int mode, float qs) {
    if (mode == 1) return v * qs;
    if (mode == 2) return siluf_(v);
    if (mode == 3) return gelu_t(v);
    return v;
}

struct Ptrs {
    const float* in[26]; float* out; unsigned char* ws;
};

__device__ __forceinline__ void transpose_item(const float* W, int K, int N, bf16_t* WT, int row_delta, LAS float* scr, int item, int lane) {
    const int nblk = N / 32, kb = item / nblk, nb = item % nblk, k0 = 64 * kb, n0 = 32 * nb;
#pragma unroll 8
    for (int i = 0; i < 32; ++i) { const int kk = 2 * i + (lane >> 5); scr[kk * 33 + (lane & 31)] = W[(size_t)(k0 + kk) * N + n0 + (lane & 31)]; }
    asm volatile("s_waitcnt lgkmcnt(0)" ::: "memory");
    const int c = lane & 7;
#pragma unroll
    for (int j = 0; j < 4; ++j) { const int n = (lane >> 3) + 8 * j; const LAS float* s = scr + (8 * c) * 33 + n;
        u32x4 o; o.x = cvt_pk_bf16(s[0 * 33], s[1 * 33]); o.y = cvt_pk_bf16(s[2 * 33], s[3 * 33]); o.z = cvt_pk_bf16(s[4 * 33], s[5 * 33]); o.w = cvt_pk_bf16(s[6 * 33], s[7 * 33]);
        *(u32x4*)(WT + (size_t)(n0 + n + row_delta) * K + k0 + 8 * c) = o; }
    asm volatile("s_waitcnt lgkmcnt(0)" ::: "memory");
}

__device__ __forceinline__ void ph_prologue(const Ptrs& P, LAS unsigned char* lds) {
    const int tid = threadIdx.x, lane = tid & 63, wid = tid >> 6, G = gridDim.x;
    unsigned char* ws = P.ws;
    {
        LAS float* cond = (LAS float*)lds;
        LAS float* part = (LAS float*)(lds + 32768);
        bool have = false;
        for (int it = blockIdx.x; it < 192; it += G) {
            if (!have) { const float* c = P.in[1]; for (int i = tid; i < 8192; i += 512) cond[i] = siluf_(c[i]); have = true; __syncthreads(); }
            const int l = it / 96, cg = it % 96, col = cg * 64 + lane;
            const float* w = P.in[2] + (size_t)l * 1024 * 6144 + col;
            float acc[8];
#pragma unroll
            for (int b = 0; b < 8; ++b) acc[b] = 0.f;
            for (int k = wid * 128; k < wid * 128 + 128; ++k) { const float wv = w[(size_t)k * 6144];
#pragma unroll
                for (int b = 0; b < 8; ++b) acc[b] += cond[b * 1024 + k] * wv; }
#pragma unroll
            for (int b = 0; b < 8; ++b) part[(wid * 8 + b) * 64 + lane] = acc[b];
            __syncthreads();
            { const int b = tid >> 6; float s = 0.f;
#pragma unroll
              for (int w8 = 0; w8 < 8; ++w8) s += part[(w8 * 8 + b) * 64 + lane];
              ((float*)(ws + WS_MOD))[(size_t)(l * 8 + b) * 6144 + col] = s + P.in[3][l * 6144 + col]; }
            __syncthreads();
        }
        __syncthreads();
    }
    LAS float* scr = (LAS float*)(lds + wid * 16384);
    const int gw = blockIdx.x * 8 + wid, NGW = G * 8;
    constexpr int I0 = 16 * 112, I1 = 512, I2 = 16 * 80, I3 = 512, IM = 256, NIT = I0 + I1 + I2 + I3 + 3 * 32 * IM;
    for (int it = gw; it < NIT; it += NGW) {
        int r = it;
        if (r < I0) { transpose_item(P.in[6], 1024, 3584, (bf16_t*)(ws + WS_WINE), 0, scr, r, lane); continue; } r -= I0;
        if (r < I1) { transpose_item(P.in[7], 1024, 1024, (bf16_t*)(ws + WS_WOUTE), 0, scr, r, lane); continue; } r -= I1;
        if (r < I2) { transpose_item(P.in[12], 1024, 2560, (bf16_t*)(ws + WS_WINO), 0, scr, r, lane); continue; } r -= I2;
        if (r < I3) { transpose_item(P.in[13], 1024, 1024, (bf16_t*)(ws + WS_WOUTO), 0, scr, r, lane); continue; } r -= I3;
        const int kind = r / (32 * IM); r -= kind * 32 * IM; const int le = r / IM, item = r % IM;
        if (kind < 2) {
            const int nb = item % 16, n0 = nb * 32; const int delta = (256 * (n0 >> 7) + 128 * kind + (n0 & 127)) - n0;
            transpose_item((kind == 0 ? P.in[23] : P.in[24]) + (size_t)le * 1024 * 512, 1024, 512, (bf16_t*)(ws + WS_GU) + (size_t)le * 1024 * 1024, delta, scr, item, lane);
        } else {
            transpose_item(P.in[25] + (size_t)le * 512 * 1024, 512, 1024, (bf16_t*)(ws + WS_DN) + (size_t)le * 1024 * 512, 0, scr, item, lane);
        }
    }
}

__device__ __forceinline__ void ph_modulate(const Ptrs& P) {
    const int tid = threadIdx.x, lane = tid & 63, wid = tid >> 6;
    const int gw = blockIdx.x * 8 + wid, NGW = gridDim.x * 8;
    const float* mod = (const float*)(P.ws + WS_MOD);
    bf16_t* H = (bf16_t*)(P.ws + WS_H);
    for (int m = gw; m < M_; m += NGW) {
        const int b = m >> 12; const float* mb = mod + (size_t)b * 6144;
        const float* xr = P.in[0] + (size_t)m * D_;
#pragma unroll
        for (int j = 0; j < 4; ++j) { const int c = 4 * lane + 256 * j;
            const f32x4 x = *(const f32x4*)(xr + c), sh = *(const f32x4*)(mb + c), sc = *(const f32x4*)(mb + 1024 + c);
            const f32x4 h = x * (1.f + sc) + sh; u32x2 o; o.x = cvt_pk_bf16(h[0], h[1]); o.y = cvt_pk_bf16(h[2], h[3]);
            *(u32x2*)(H + (size_t)m * D_ + c) = o; }
    }
}

__device__ __forceinline__ void ph_lnr(const Ptrs& P, int l, LAS unsigned char* lds) {
    const int tid = threadIdx.x, lane = tid & 63, wid = tid >> 6, G = gridDim.x;
    unsigned char* ws = P.ws;
    LAS f32x4* RW = (LAS f32x4*)lds;
    LAS int* se = (LAS int*)(lds + 65536);
    LAS int* hist = (LAS int*)(lds + 65536 + 1024);
    LAS int* base = (LAS int*)(lds + 65536 + 1024 + 64);
    LAS int* rnk = (LAS int*)(lds + 65536 + 2048);
    const float* rw = P.in[21];
    for (int i = tid; i < 4096; i += 512) { const int idx = i >> 6, ln = i & 63, q = idx & 3, ji = idx >> 2, j = ji >> 2, ii = ji & 3; const int c = 4 * ln + 256 * j + ii;
        RW[i] = *(const f32x4*)(rw + (size_t)c * 16 + 4 * q); }
    if (tid < 16) hist[tid] = 0;
    __syncthreads();
    const float* mod = (const float*)(ws + WS_MOD) + (size_t)l * 8 * 6144;
    const float* xsrc = (l == 0) ? P.in[0] : P.out;
    const bf16_t* Y = (const bf16_t*)(ws + WS_P);
    bf16_t* H = (bf16_t*)(ws + WS_H);
    TokInfo* tok = (TokInfo*)(ws + WS_TOK);
    int* list = (int*)(ws + WS_LIST);
    unsigned* gcnt = (unsigned*)(ws + WS_CTL) + CW_GCNT + l * 16;
    const float* lng = P.in[4] + (size_t)(l * 2 + 0) * 1024, * lnb = P.in[5] + (size_t)(l * 2 + 0) * 1024;
    float rb[16];
#pragma unroll
    for (int e = 0; e < 16; ++e) rb[e] = P.in[22][e];
    for (int ch = blockIdx.x; ch < M_ / 128; ch += G) {
        const int b = (ch * 128) >> 12; const float* mb = mod + (size_t)b * 6144;
        for (int i = 0; i < 16; ++i) {
            const int rl = wid * 16 + i, m = ch * 128 + rl;
            f32x4 v[4]; float s = 0.f;
#pragma unroll
            for (int j = 0; j < 4; ++j) { const int c = 4 * lane + 256 * j;
                const f32x4 x = *(const f32x4*)(xsrc + (size_t)m * D_ + c); const u32x2 yb = *(const u32x2*)(Y + (size_t)m * D_ + c);
                const f32x4 g1 = *(const f32x4*)(mb + 2048 + c);
                f32x4 y; y[0] = __uint_as_float(yb.x << 16); y[1] = __uint_as_float(yb.x & 0xffff0000u); y[2] = __uint_as_float(yb.y << 16); y[3] = __uint_as_float(yb.y & 0xffff0000u);
                v[j] = ALPHA * x + (1.f + g1) * y; s += (v[j][0] + v[j][1]) + (v[j][2] + v[j][3]); }
            const float mean = wave_sum(s) * (1.f / D_); float s2 = 0.f;
#pragma unroll
            for (int j = 0; j < 4; ++j) { v[j] = v[j] - mean; s2 += (v[j][0] * v[j][0] + v[j][1] * v[j][1]) + (v[j][2] * v[j][2] + v[j][3] * v[j][3]); }
            const float rstd = 1.f / sqrtf(wave_sum(s2) * (1.f / D_) + LN_EPS);
            float acc[16];
#pragma unroll
            for (int e = 0; e < 16; ++e) acc[e] = 0.f;
#pragma unroll
            for (int j = 0; j < 4; ++j) { const int c = 4 * lane + 256 * j;
                const f32x4 g = *(const f32x4*)(lng + c), bb = *(const f32x4*)(lnb + c);
                const f32x4 x1 = v[j] * rstd * g + bb;
                *(f32x4*)(P.out + (size_t)m * D_ + c) = x1;
                const f32x4 sh = *(const f32x4*)(mb + 3072 + c), sc = *(const f32x4*)(mb + 4096 + c);
                const f32x4 h = x1 * (1.f + sc) + sh; u32x2 o; o.x = cvt_pk_bf16(h[0], h[1]); o.y = cvt_pk_bf16(h[2], h[3]);
                *(u32x2*)(H + (size_t)m * D_ + c) = o;
#pragma unroll
                for (int ii = 0; ii < 4; ++ii)
#pragma unroll
                    for (int q = 0; q < 4; ++q) { const f32x4 w = RW[((j * 4 + ii) * 4 + q) * 64 + lane];
                        acc[4 * q + 0] += h[ii] * w[0]; acc[4 * q + 1] += h[ii] * w[1]; acc[4 * q + 2] += h[ii] * w[2]; acc[4 * q + 3] += h[ii] * w[3]; }
                asm volatile("" ::: "memory");
            }
            float p[16]; float mx = -1e30f;
#pragma unroll
            for (int e = 0; e < 16; ++e) { p[e] = wave_sum(acc[e]) + rb[e]; mx = fmaxf(mx, p[e]); }
            float ps = 0.f;
#pragma unroll
            for (int e = 0; e < 16; ++e) { p[e] = expf(p[e] - mx); ps += p[e]; }
            const float inv = 1.f / ps;
#pragma unroll
            for (int e = 0; e < 16; ++e) p[e] *= inv;
            int gs = 0; float best = -1.f, q0 = 0.f, q1 = 0.f, q2 = 0.f, q3 = 0.f;
#pragma unroll
            for (int g = 0; g < 4; ++g) { const float a = p[4 * g], b2 = p[4 * g + 1], c2 = p[4 * g + 2], d2 = p[4 * g + 3];
                const float t2 = fmaxf(fmaxf(fmaxf(a + b2, a + c2), fmaxf(a + d2, b2 + c2)), fmaxf(b2 + d2, c2 + d2));
                const bool better = t2 > best;
                best = better ? t2 : best; gs = better ? g : gs; q0 = better ? a : q0; q1 = better ? b2 : q1; q2 = better ? c2 : q2; q3 = better ? d2 : q3; }
            int i1 = 0; float t1 = q0;
            if (q1 > t1) { t1 = q1; i1 = 1; } if (q2 > t1) { t1 = q2; i1 = 2; } if (q3 > t1) { t1 = q3; i1 = 3; }
            int i2 = -1; float t2v = -1.f;
            if (i1 != 0 && q0 > t2v) { t2v = q0; i2 = 0; } if (i1 != 1 && q1 > t2v) { t2v = q1; i2 = 1; }
            if (i1 != 2 && q2 > t2v) { t2v = q2; i2 = 2; } if (i1 != 3 && q3 > t2v) { t2v = q3; i2 = 3; }
            const float wsum = t1 + t2v;
            if (lane == 0) { se[rl * 2 + 0] = gs * 4 + i1; se[rl * 2 + 1] = gs * 4 + i2; tok[m].w1 = t1 / wsum; tok[m].w2 = t2v / wsum; }
        }
        __syncthreads();
        int e = 0, rank = 0;
        if (tid < 256) { e = se[tid]; rank = atomicAdd((int*)&hist[e], 1); }
        __syncthreads();
        if (tid < 16) { base[tid] = (int)__hip_atomic_fetch_add(gcnt + tid, (unsigned)hist[tid], __ATOMIC_RELAXED, __HIP_MEMORY_SCOPE_AGENT); }
        __syncthreads();
        if (tid < 256) { const int pos = base[e] + rank, m = ch * 128 + (tid >> 1); list[(size_t)e * M_ + pos] = m;
            if (tid & 1) tok[m].ep2 = (e << 20) | pos; else tok[m].ep1 = (e << 20) | pos; }
        if (tid < 16) hist[tid] = 0;
        __syncthreads();
    }
}

template <bool NAIVE_Y>
__device__ __forceinline__ void ph_ln2(const Ptrs& P, int l, LAS unsigned char* lds) {
    const int tid = threadIdx.x, lane = tid & 63, wid = tid >> 6;
    unsigned char* ws = P.ws;
    LAS int* segrow = (LAS int*)lds;
    if (tid == 0) { const unsigned* gcnt = (const unsigned*)(ws + WS_CTL) + CW_GCNT + l * 16; int acc = 0;
        for (int e = 0; e < 16; ++e) { segrow[e] = acc; const unsigned c = __hip_atomic_load(gcnt + e, __ATOMIC_RELAXED, __HIP_MEMORY_SCOPE_AGENT); acc += (int)((c + 255u) >> 8) * 256; } }
    __syncthreads();
    const float* mod = (const float*)(ws + WS_MOD);
    const bf16_t* YS = (const bf16_t*)(ws + WS_YS);
    const TokInfo* tok = (const TokInfo*)(ws + WS_TOK);
    bf16_t* H = (bf16_t*)(ws + WS_H);
    const float* lng = P.in[4] + (size_t)(l * 2 + 1) * 1024, * lnb = P.in[5] + (size_t)(l * 2 + 1) * 1024;
    const int gw = blockIdx.x * 8 + wid, NGW = gridDim.x * 8;
    for (int m = gw; m < M_; m += NGW) {
        const int b = m >> 12; const float* mb = mod + (size_t)(l * 8 + b) * 6144;
        const TokInfo ti = tok[m];
        const size_t r1 = NAIVE_Y ? (size_t)m : (size_t)(segrow[ti.ep1 >> 20] + (ti.ep1 & 0xfffff));
        const size_t r2 = NAIVE_Y ? (size_t)m : (size_t)(segrow[ti.ep2 >> 20] + (ti.ep2 & 0xfffff));
        f32x4 v[4]; float s = 0.f;
#pragma unroll
        for (int j = 0; j < 4; ++j) { const int c = 4 * lane + 256 * j;
            const f32x4 x = *(const f32x4*)(P.out + (size_t)m * D_ + c); const f32x4 g2 = *(const f32x4*)(mb + 5120 + c);
            const u32x2 ya = *(const u32x2*)(YS + r1 * D_ + c);
            f32x4 y; y[0] = __uint_as_float(ya.x << 16); y[1] = __uint_as_float(ya.x & 0xffff0000u); y[2] = __uint_as_float(ya.y << 16); y[3] = __uint_as_float(ya.y & 0xffff0000u);
            if (!NAIVE_Y) { const u32x2 yb = *(const u32x2*)(YS + r2 * D_ + c);
                f32x4 y2; y2[0] = __uint_as_float(yb.x << 16); y2[1] = __uint_as_float(yb.x & 0xffff0000u); y2[2] = __uint_as_float(yb.y << 16); y2[3] = __uint_as_float(yb.y & 0xffff0000u);
                y = ti.w1 * y + ti.w2 * y2; }
            v[j] = ALPHA * x + (1.f + g2) * y; s += (v[j][0] + v[j][1]) + (v[j][2] + v[j][3]); }
        const float mean = wave_sum(s) * (1.f / D_); float s2 = 0.f;
#pragma unroll
        for (int j = 0; j < 4; ++j) { v[j] = v[j] - mean; s2 += (v[j][0] * v[j][0] + v[j][1] * v[j][1]) + (v[j][2] * v[j][2] + v[j][3] * v[j][3]); }
        const float rstd = 1.f / sqrtf(wave_sum(s2) * (1.f / D_) + LN_EPS);
#pragma unroll
        for (int j = 0; j < 4; ++j) { const int c = 4 * lane + 256 * j;
            const f32x4 g = *(const f32x4*)(lng + c), bb = *(const f32x4*)(lnb + c);
            const f32x4 x2 = v[j] * rstd * g + bb;
            *(f32x4*)(P.out + (size_t)m * D_ + c) = x2;
            if (l == 0) { const float* mb1 = mod + (size_t)(8 + b) * 6144;
                const f32x4 sh = *(const f32x4*)(mb1 + c), sc = *(const f32x4*)(mb1 + 1024 + c);
                const f32x4 h = x2 * (1.f + sc) + sh; u32x2 o; o.x = cvt_pk_bf16(h[0], h[1]); o.y = cvt_pk_bf16(h[2], h[3]);
                *(u32x2*)(H + (size_t)m * D_ + c) = o; }
        }
    }
}

__global__ void __launch_bounds__(256) ngemm(const bf16_t* A, const bf16_t* Bt, bf16_t* C, int N, int K, unsigned long long modes, float qs) {
    __shared__ float As[32][65], Bs[32][65];
    const int tid = threadIdx.x, tx = tid & 15, ty = tid >> 4;
    const int m0 = blockIdx.y * 64, n0 = blockIdx.x * 64;
    float acc[4][4] = {};
    const int lr = tid >> 2, lk = (tid & 3) * 8;
    for (int k0 = 0; k0 < K; k0 += 32) {
        const bf16x8 av = *(const bf16x8*)(A + (size_t)(m0 + lr) * K + k0 + lk), bv = *(const bf16x8*)(Bt + (size_t)(n0 + lr) * K + k0 + lk);
#pragma unroll
        for (int i = 0; i < 8; ++i) { As[lk + i][lr] = bf2f((bf16_t)av[i]); Bs[lk + i][lr] = bf2f((bf16_t)bv[i]); }
        __syncthreads();
#pragma unroll 8
        for (int kk = 0; kk < 32; ++kk) { float a[4], b[4];
#pragma unroll
            for (int i = 0; i < 4; ++i) { a[i] = As[kk][ty * 4 + i]; b[i] = Bs[kk][tx * 4 + i]; }
#pragma unroll
            for (int i = 0; i < 4; ++i)
#pragma unroll
                for (int j = 0; j < 4; ++j) acc[i][j] += a[i] * b[j]; }
        __syncthreads();
    }
    const int mode = (int)((modes >> (4 * (n0 >> 8))) & 15ull);
#pragma unroll
    for (int i = 0; i < 4; ++i)
#pragma unroll
        for (int j = 0; j < 4; ++j) C[(size_t)(m0 + ty * 4 + i) * N + n0 + tx * 4 + j] = f2bf(act_mode(acc[i][j], mode, qs));
}

__global__ void __launch_bounds__(256) nda(const bf16_t* proj, bf16_t* mix, const float* dlam, const float* gain) {
    const int lane = threadIdx.x & 63, rid = blockIdx.x * 4 + (threadIdx.x >> 6);
    const int h = rid & 3, tokn = rid >> 2, b = tokn >> 12, i = tokn & 4095;
    float d01 = 0.f, d23 = 0.f;
    { const float a = dlam[lane] * dlam[64 + lane], c = dlam[128 + lane] * dlam[192 + lane]; d01 = wave_sum(a); d23 = wave_sum(c); }
    const float lam = expf(d01) - expf(d23) + LAM_INIT0;
    const float slope2 = exp2f(-2.f * (float)(h + 1)) * LOG2E;
    const bf16_t* qrow = proj + (size_t)tokn * P0 + h * 128;
    const size_t rb = (size_t)b * T_;
    float m0 = -1e30f, l0 = 0.f, m1 = -1e30f, l1 = 0.f;
    const int nch = (i >> 6) + 1;
    for (int jb = 0; jb < nch; ++jb) {
        const int j = jb * 64 + lane; const bool valid = j <= i;
        const bf16_t* krow = proj + (rb + (valid ? j : i)) * P0 + 512 + h * 128;
        float s0 = 0.f, s1 = 0.f;
        for (int d = 0; d < 64; ++d) { s0 += bf2f(qrow[d]) * bf2f(krow[d]); s1 += bf2f(qrow[64 + d]) * bf2f(krow[64 + d]); }
        const float bias = -slope2 * (float)(i - j); s0 += bias; s1 += bias;
        if (valid) { float mn = fmaxf(m0, s0); l0 = l0 * fexp2(m0 - mn) + fexp2(s0 - mn); m0 = mn; mn = fmaxf(m1, s1); l1 = l1 * fexp2(m1 - mn) + fexp2(s1 - mn); m1 = mn; }
    }
    const float M0 = wave_max(m0), M1 = wave_max(m1);
    const float L0 = wave_sum(l0 * fexp2(m0 - M0)), L1 = wave_sum(l1 * fexp2(m1 - M1));
    const float i0 = 1.f / L0, i1 = lam / L1;
    float o0 = 0.f, o1 = 0.f;
    for (int jb = 0; jb < nch; ++jb) {
        const int j = jb * 64 + lane; const bool valid = j <= i;
        const bf16_t* krow = proj + (rb + (valid ? j : i)) * P0 + 512 + h * 128;
        float s0 = 0.f, s1 = 0.f;
        for (int d = 0; d < 64; ++d) { s0 += bf2f(qrow[d]) * bf2f(krow[d]); s1 += bf2f(qrow[64 + d]) * bf2f(krow[64 + d]); }
        const float bias = -slope2 * (float)(i - j); s0 += bias; s1 += bias;
        const float a = valid ? (fexp2(s0 - M0) * i0 - fexp2(s1 - M1) * i1) : 0.f;
        const int jmax = min(64, i + 1 - jb * 64);
        for (int jj = 0; jj < jmax; ++jj) { const float aj = __shfl(a, jj); const bf16_t* vrow = proj + (rb + jb * 64 + jj) * P0 + 1024 + h * 128;
            o0 += aj * bf2f(vrow[lane]); o1 += aj * bf2f(vrow[64 + lane]); }
    }
    const float ssq = wave_sum(o0 * o0 + o1 * o1);
    const float rstd = 1.f / sqrtf(ssq * (1.f / 128.f) + RMS_EPS);
    bf16_t* orow = mix + (size_t)tokn * D_ + h * 128;
    orow[lane] = f2bf(o0 * rstd * gain[lane] * (1.f - LAM_INIT0)); orow[64 + lane] = f2bf(o1 * rstd * gain[64 + lane] * (1.f - LAM_INIT0));
}

__global__ void __launch_bounds__(512) nhg(const bf16_t* proj, bf16_t* mix, const float* gamma, const float* hgain) {
    __shared__ float qs[128], fs[128], ks[128], part[4][128], red[2];
    const int tid = threadIdx.x, dv = tid & 127, dq = tid >> 7, b = blockIdx.x >> 2, h = blockIdx.x & 3;
    float lb = 0.f;
    if (tid < 128) { const int c = h * 128 + tid; const float g0 = gamma[c], g1 = gamma[512 + c], g2 = gamma[1024 + c]; const float mx = fmaxf(g0, fmaxf(g1, g2));
        const float e0 = expf(g0 - mx), e1 = expf(g1 - mx), e2 = expf(g2 - mx); lb = e0 / (e0 + e1 + e2); }
    float S[32];
#pragma unroll
    for (int r = 0; r < 32; ++r) S[r] = 0.f;
    const float gn = hgain[dv];
    for (int t = 0; t < T_; ++t) {
        const bf16_t* row = proj + ((size_t)b * T_ + t) * P0;
        if (tid < 128) { const float q = bf2f(row[1536 + h * 128 + tid]), fl = bf2f(row[2048 + h * 128 + tid]);
            const float f = lb + (1.f - lb) * sigmoidf_(fl); qs[tid] = q; fs[tid] = f; ks[tid] = 1.f - f; }
        const float v = bf2f(row[2560 + h * 128 + dv]);
        __syncthreads();
        float p = 0.f;
#pragma unroll
        for (int r = 0; r < 32; ++r) { const int dk = dq * 32 + r; S[r] = fs[dk] * S[r] + ks[dk] * v; p += qs[dk] * S[r]; }
        part[dq][dv] = p;
        __syncthreads();
        float o = 0.f;
        if (tid < 128) { o = part[0][dv] + part[1][dv] + part[2][dv] + part[3][dv]; const float ss = wave_sum(o * o); if ((tid & 63) == 0) red[tid >> 6] = ss; }
        __syncthreads();
        if (tid < 128) { const float rstd = 1.f / sqrtf((red[0] + red[1]) * (1.f / 128.f) + RMS_EPS);
            mix[((size_t)b * T_ + t) * D_ + 512 + h * 128 + dv] = f2bf(o * rstd * gn * bf2f(row[3072 + h * 128 + dv])); }
    }
}

__global__ void __launch_bounds__(64) nlru(const bf16_t* proj, bf16_t* mix, const float* convw, const float* convb, const float* wa, const float* ba, const float* wx, const float* bx, const float* lam) {
    __shared__ float WA[64][64], WX[64][64], xcs[64];
    const int lane = threadIdx.x, b = blockIdx.x >> 3, g = blockIdx.x & 7, c = g * 64 + lane;
    for (int i = 0; i < 64; ++i) { WA[i][lane] = wa[(size_t)(g * 64 + i) * 64 + lane]; WX[i][lane] = wx[(size_t)(g * 64 + i) * 64 + lane]; }
    const float w0 = convw[c], w1 = convw[512 + c], w2 = convw[1024 + c], w3 = convw[1536 + c], cb = convb[c];
    const float bav = ba[c], bxv = bx[c], sp = softplusf_(-lam[c]);
    float x3 = 0.f, x2 = 0.f, x1 = 0.f, hst = 0.f;
    __syncthreads();
    for (int t = 0; t < T_; ++t) {
        const bf16_t* row = proj + ((size_t)b * T_ + t) * P1;
        const float xr = bf2f(row[c]);
        const float xc = w0 * x3 + w1 * x2 + w2 * x1 + w3 * xr + cb; x3 = x2; x2 = x1; x1 = xr;
        xcs[lane] = xc;
        __syncthreads();
        float ga = bav, gx = bxv;
#pragma unroll 16
        for (int i = 0; i < 64; ++i) { const float xv = xcs[i]; ga += xv * WA[i][lane]; gx += xv * WX[i][lane]; }
        __syncthreads();
        const float r = sigmoidf_(ga), ii = sigmoidf_(gx);
        const float la = -8.f * r * sp, a = expf(la);
        const float u = sqrtf(fmaxf(-expm1f(2.f * la), 1e-12f)) * (ii * xc);
        hst = a * hst + u;
        mix[((size_t)b * T_ + t) * D_ + c] = f2bf(bf2f(row[512 + c]) * hst);
    }
}

__global__ void __launch_bounds__(256) nsb(const bf16_t* proj, bf16_t* mix) {
    const int lane = threadIdx.x & 63, rid = blockIdx.x * 4 + (threadIdx.x >> 6);
    const int h = rid & 7, tokn = rid >> 3, b = tokn >> 12, i = tokn & 4095;
    const bf16_t* qrow = proj + (size_t)tokn * P1 + 1024 + h * 64;
    const size_t rb = (size_t)b * T_;
    float o = 0.f, carry = 0.f;
    for (int jb = (i - 1) >> 6; jb >= 0 && i > 0; --jb) {
        const int j = jb * 64 + lane; const bool valid = j < i;
        const bf16_t* krow = proj + (rb + (valid ? j : 0)) * P1 + 1536 + h * 64;
        float z = 0.f;
        for (int d = 0; d < 64; ++d) z += bf2f(qrow[d]) * bf2f(krow[d]);
        z *= LN2F;
        const float spz = softplusf_(z);
        const float l1m = valid ? -spz : 0.f;
        float inc = l1m;
#pragma unroll
        for (int off = 1; off < 64; off <<= 1) { const float t = __shfl_down(inc, off); if (lane + off < 64) inc += t; }
        const float after = carry + (inc - l1m);
        const float a = valid ? expf((z - spz) + after) : 0.f;
        carry += __shfl(inc, 0);
        const int jmax = min(64, i - jb * 64);
        for (int jj = 0; jj < jmax; ++jj) { const float aj = __shfl(a, jj); o += aj * bf2f(proj[(rb + jb * 64 + jj) * P1 + 2048 + h * 64 + lane]); }
    }
    mix[(size_t)tokn * D_ + 512 + h * 64 + lane] = f2bf(o);
}

__global__ void __launch_bounds__(256) nmoe(const bf16_t* H, const TokInfo* tok, const bf16_t* GU, const bf16_t* DN, bf16_t* ymoe) {
    __shared__ float hs[1024], he[512];
    const int tid = threadIdx.x, m = blockIdx.x;
    for (int i = tid; i < 1024; i += 256) hs[i] = bf2f(H[(size_t)m * D_ + i]);
    const TokInfo ti = tok[m];
    float y[4] = {0.f, 0.f, 0.f, 0.f};
    __syncthreads();
    for (int k = 0; k < 2; ++k) {
        const int e = (k == 0 ? ti.ep1 : ti.ep2) >> 20; const float w = k == 0 ? ti.w1 : ti.w2;
        for (int jj = 0; jj < 2; ++jj) { const int j = tid + 256 * jj; const int rg = 256 * (j >> 7) + (j & 127);
            const bf16_t* gr = GU + ((size_t)e * 1024 + rg) * 1024, * ur = gr + 128 * 1024;
            float g = 0.f, u = 0.f;
            for (int kk = 0; kk < 1024; kk += 8) { const bf16x8 gv = *(const bf16x8*)(gr + kk), uv = *(const bf16x8*)(ur + kk);
#pragma unroll
                for (int i = 0; i < 8; ++i) { g += hs[kk + i] * bf2f((bf16_t)gv[i]); u += hs[kk + i] * bf2f((bf16_t)uv[i]); } }
            he[j] = bf2f(f2bf(siluf_(g) * u)); }
        __syncthreads();
        for (int nn = 0; nn < 4; ++nn) { const int n = tid + 256 * nn; const bf16_t* dr = DN + ((size_t)e * 1024 + n) * 512; float s = 0.f;
            for (int kk = 0; kk < 512; kk += 8) { const bf16x8 dv = *(const bf16x8*)(dr + kk);
#pragma unroll
                for (int i = 0; i < 8; ++i) s += he[kk + i] * bf2f((bf16_t)dv[i]); }
            y[nn] += w * s; }
        __syncthreads();
    }
    for (int nn = 0; nn < 4; ++nn) ymoe[(size_t)m * D_ + tid + 256 * nn] = f2bf(y[nn]);
}

namespace pg8 {
constexpr int BM = 256, BK = 64, HALF = 128, HTB = HALF * BK * 2, STAGE_BYTES = 8 * HTB, NXCD = 8, WGM = 8;
__host__ __device__ __forceinline__ int lds_byte(int r, int c) { const int st = (r >> 4) * 2 + (c >> 5), rr = r & 15, cc = c & 31, ob = rr * 64 + cc * 2; return st * 1024 + (ob ^ (((ob >> 9) & 1) << 5)); }
__host__ __device__ __forceinline__ void stage_rc(int b, int& R, int& C) { const int st = b / 1024, sb = b % 1024, swz = sb ^ (((sb >> 9) & 1) << 5); R = (st >> 1) * 16 + swz / 64; C = (st & 1) * 32 + (swz % 64) / 2; }
__host__ __device__ __forceinline__ int perm32(int rho) { const int n = rho >> 4, i = rho & 15; return 8 * (i >> 2) + 4 * n + (i & 3); }
struct Unit { int pm, pn, e, nvalid; const int* rowmap; };
struct Gemm { const bf16_t* A; const bf16_t* Bt; int K; size_t bstride; };

struct StaticOrder {
    int nM, nN, nwg, G, c;
    __device__ void init(int M, int N, int G_, int c_) { nM = M / BM; nN = N / BM; nwg = nM * nN; G = G_; c = c_; }
    __device__ bool next(int i, Unit& u) const {
        const long L = (long)i * G + c; if (L >= nwg) return false;
        int wgid = (int)L; { const int q = nwg / NXCD, r = nwg % NXCD, xcd = wgid % NXCD, off = wgid / NXCD; wgid = (xcd < r ? xcd * (q + 1) : r * (q + 1) + (xcd - r) * q) + off; }
        const int nig = WGM * nN, gid = wgid / nig, fm = gid * WGM, gsz = (nM - fm) < WGM ? (nM - fm) : WGM;
        u.pm = fm + ((wgid % nig) % gsz); u.pn = (wgid % nig) / gsz; u.e = 0; u.nvalid = 256; u.rowmap = nullptr; return true;
    }
};
struct MoeOrder {
    const LAS int* tab; const int* list; int G, c, npn;
    __device__ bool next(int i, Unit& u) const {
        const int L = i * G + c; const int total = tab[16] * npn; if (L >= total) return false;
        const int tile = L / npn; u.pn = L - tile * npn; int e = 0;
#pragma unroll
        for (int j = 1; j < 16; ++j) e += (tile >= tab[j]) ? 1 : 0;
        const int mt = tile - tab[e]; u.pm = tile; u.e = e; const int rem = tab[32 + e] - mt * 256; u.nvalid = rem < 256 ? rem : 256;
        u.rowmap = list + (size_t)e * M_ + mt * 256; return true;
    }
};

template <int MODE> __device__ __forceinline__ f32x4 act4(f32x4 v, float qs) {
    if (MODE == 1) return v * qs;
    if (MODE == 2) { f32x4 o; o[0] = siluf_(v[0]); o[1] = siluf_(v[1]); o[2] = siluf_(v[2]); o[3] = siluf_(v[3]); return o; }
    if (MODE == 3) { f32x4 o; o[0] = gelu_t(v[0]); o[1] = gelu_t(v[1]); o[2] = gelu_t(v[2]); o[3] = gelu_t(v[3]); return o; }
    return v;
}
struct EpiAct {
    static constexpr bool PERM = true;
    bf16_t* O; int ldc; unsigned long long modes; float qs;
    template <int MODE> __device__ __forceinline__ void store(const f32x4 (&acc)[2][2][4][2], const Unit& u, int wr, int wc, int fr, int fq) const {
        const int row0 = u.pm * BM + wr * 64 + fr, col0 = u.pn * BM + wc * 32 + 8 * fq;
#pragma unroll
        for (int ai = 0; ai < 2; ++ai)
#pragma unroll
            for (int m = 0; m < 4; ++m) { bf16_t* rowp = O + (size_t)(row0 + ai * HALF + m * 16) * ldc + col0;
#pragma unroll
                for (int bj = 0; bj < 2; ++bj) { const f32x4 v0 = act4<MODE>(acc[ai][bj][m][0], qs), v1 = act4<MODE>(acc[ai][bj][m][1], qs);
                    u32x4 w; w.x = cvt_pk_bf16(v0[0], v0[1]); w.y = cvt_pk_bf16(v0[2], v0[3]); w.z = cvt_pk_bf16(v1[0], v1[1]); w.w = cvt_pk_bf16(v1[2], v1[3]);
                    *(u32x4*)(rowp + bj * HALF) = w; } }
    }
    __device__ __forceinline__ void operator()(const f32x4 (&acc)[2][2][4][2], const Unit& u, int wr, int wc, int fr, int fq) const {
        const int mode = (int)((modes >> (4 * u.pn)) & 15ull);
        if (mode == 0) store<0>(acc, u, wr, wc, fr, fq); else if (mode == 1) store<1>(acc, u, wr, wc, fr, fq); else if (mode == 2) store<2>(acc, u, wr, wc, fr, fq); else store<3>(acc, u, wr, wc, fr, fq);
    }
};
struct EpiGU {
    static constexpr bool PERM = true;
    bf16_t* O;
    __device__ __forceinline__ void operator()(const f32x4 (&acc)[2][2][4][2], const Unit& u, int wr, int wc, int fr, int fq) const {
        const int row0 = u.pm * BM + wr * 64 + fr, col0 = u.pn * HALF + wc * 32 + 8 * fq;
#pragma unroll
        for (int ai = 0; ai < 2; ++ai)
#pragma unroll
            for (int m = 0; m < 4; ++m) { f32x4 v0 = act4<2>(acc[ai][0][m][0], 1.f) * acc[ai][1][m][0], v1 = act4<2>(acc[ai][0][m][1], 1.f) * acc[ai][1][m][1];
                u32x4 w; w.x = cvt_pk_bf16(v0[0], v0[1]); w.y = cvt_pk_bf16(v0[2], v0[3]); w.z = cvt_pk_bf16(v1[0], v1[1]); w.w = cvt_pk_bf16(v1[2], v1[3]);
                *(u32x4*)(O + (size_t)(row0 + ai * HALF + m * 16) * 512 + col0) = w; }
    }
};

template <class Epi, class Sched, bool ALIGN_EPI, bool GATHER>
__device__ __forceinline__ void gemm_phase(LAS unsigned char* lds, const Gemm g, const Sched& S, const Epi& E) {
    const int tid = threadIdx.x, wid = __builtin_amdgcn_readfirstlane(tid >> 6), lane = tid & 63, wr = wid >> 2, wc = wid & 3, fr = lane & 15, fq = lane >> 4;
    const int K = g.K, nt = K / BK;
    int Rst[2], Cst[2]; unsigned voffB[2];
#pragma unroll
    for (int i = 0; i < 2; ++i) { int R, C; stage_rc(tid * 16 + i * 8192, R, C); const int Rb = Epi::PERM ? ((R & ~31) + perm32(R & 31)) : R;
        Rst[i] = R; Cst[i] = C; voffB[i] = (unsigned)(Rb * K + C) * 2u; }
    const size_t kstep = (size_t)(BK * 2);
    const size_t hstep = (size_t)HALF * K * 2;
    const size_t tstep = 2 * hstep;
    const unsigned ldsw = (unsigned)wid * 1024u;
    const int aoff = lds_byte(wr * 64 + fr, fq * 8), boff = lds_byte(wc * 32 + fr, fq * 8);
#define PG8_SA(b, h) (((b) * 2 + (h)) * HTB)
#define PG8_SB(b, h) ((4 + (b) * 2 + (h)) * HTB)
#define PG8_STAGE(bufoff, gbase, voff) do { _Pragma("unroll") for (int _i = 0; _i < 2; ++_i) \
        __builtin_amdgcn_global_load_lds((const unsigned*)((const char*)(gbase) + (voff)[_i]), (LAS unsigned*)(lds + (bufoff) + ldsw + _i * 8192), 16, 0, 0); } while (0)
#define PG8_LDA(dst, b, h) do { _Pragma("unroll") for (int m = 0; m < 4; ++m) _Pragma("unroll") for (int k = 0; k < 2; ++k) dst[m][k] = *(const LAS bf16x8*)(lds + PG8_SA(b, h) + aoff + m * 2048 + k * 1024); } while (0)
#define PG8_LDB(dst, b, h) do { _Pragma("unroll") for (int n = 0; n < 2; ++n) _Pragma("unroll") for (int k = 0; k < 2; ++k) dst[n][k] = *(const LAS bf16x8*)(lds + PG8_SB(b, h) + boff + n * 2048 + k * 1024); } while (0)
#define PG8_MMA(ai, bj, At, Bt) do { __builtin_amdgcn_s_setprio(1); _Pragma("unroll") for (int m = 0; m < 4; ++m) _Pragma("unroll") for (int n = 0; n < 2; ++n) _Pragma("unroll") for (int k = 0; k < 2; ++k) \
        acc[ai][bj][m][n] = __builtin_amdgcn_mfma_f32_16x16x32_bf16(Bt[n][k], At[m][k], acc[ai][bj][m][n], 0, 0, 0); __builtin_amdgcn_s_setprio(0); } while (0)
#define PG8_WAIT_V(n) asm volatile("s_waitcnt vmcnt(" #n ")" ::: "memory")
#define PG8_WAIT_L(n) asm volatile("s_waitcnt lgkmcnt(" #n ")" ::: "memory")
#define PG8_BAR __builtin_amdgcn_s_barrier()
#define PG8_SCHED __builtin_amdgcn_sched_barrier(0)
#define PG8_VOA(vo, un) do { _Pragma("unroll") for (int _h = 0; _h < 2; ++_h) _Pragma("unroll") for (int _i = 0; _i < 2; ++_i) { \
        if constexpr (GATHER) { const int _r = _h * HALF + Rst[_i]; const int _row = (_r < (un).nvalid) ? (un).rowmap[_r] : 0; vo[_h][_i] = (unsigned)(_row * K + Cst[_i]) * 2u; } \
        else vo[_h][_i] = (unsigned)(Rst[_i] * K + Cst[_i]) * 2u + (unsigned)(_h * hstep); } } while (0)
    Unit cur, nxt; int ui = 0;
    if (!S.next(0, cur)) return;
    f32x4 acc[2][2][4][2];
#pragma unroll
    for (int a = 0; a < 2; ++a)
#pragma unroll
        for (int b = 0; b < 2; ++b)
#pragma unroll
            for (int m = 0; m < 4; ++m)
#pragma unroll
                for (int n = 0; n < 2; ++n) acc[a][b][m][n] = (f32x4){0.f, 0.f, 0.f, 0.f};
    bf16x8 At[4][2], B0[2][2], B1[2][2];
    unsigned voA[2][2], voN[2][2];
    PG8_VOA(voA, cur);
    const char* cA = GATHER ? (const char*)g.A : (const char*)g.A + (size_t)cur.pm * tstep;
    const char* cB = (const char*)g.Bt + ((size_t)cur.e * g.bstride) * 2 + (size_t)cur.pn * tstep;
    PG8_STAGE(PG8_SB(0, 0), cB, voffB); PG8_STAGE(PG8_SB(0, 1), cB + hstep, voffB); PG8_STAGE(PG8_SA(0, 0), cA, voA[0]); PG8_STAGE(PG8_SA(0, 1), cA, voA[1]);
    if (wr == 1) PG8_BAR;
    PG8_WAIT_V(2); PG8_BAR;
    PG8_STAGE(PG8_SB(1, 0), cB + kstep, voffB); PG8_STAGE(PG8_SA(1, 0), cA + kstep, voA[0]); PG8_STAGE(PG8_SB(1, 1), cB + hstep + kstep, voffB);
    PG8_WAIT_V(6); PG8_BAR;
    for (;;) {
        const bool has_next = S.next(ui + 1, nxt);
        const char* nA = cA; const char* nB = cB;
        if (has_next) { nA = GATHER ? (const char*)g.A : (const char*)g.A + (size_t)nxt.pm * tstep; nB = (const char*)g.Bt + ((size_t)nxt.e * g.bstride) * 2 + (size_t)nxt.pn * tstep; PG8_VOA(voN, nxt); }
        else {
#pragma unroll
            for (int _h = 0; _h < 2; ++_h)
#pragma unroll
                for (int _i = 0; _i < 2; ++_i) voN[_h][_i] = voA[_h][_i]; }
        for (int t = 0; t < nt; t += 2) {
            const bool last = (t == nt - 2);
            const char* a1 = cA + (size_t)(t + 1) * kstep;
            const char* a2 = last ? nA : cA + (size_t)(t + 2) * kstep; const char* b2 = last ? nB : cB + (size_t)(t + 2) * kstep;
            const char* a3 = a2 + kstep; const char* b3 = b2 + kstep;
            unsigned vo2[2][2];
#pragma unroll
            for (int _h = 0; _h < 2; ++_h)
#pragma unroll
                for (int _i = 0; _i < 2; ++_i) vo2[_h][_i] = last ? voN[_h][_i] : voA[_h][_i];
            PG8_LDB(B0, 0, 0); PG8_LDB(B1, 0, 1); PG8_SCHED; PG8_LDA(At, 0, 0); PG8_STAGE(PG8_SA(1, 1), a1, voA[1]);
            PG8_WAIT_V(8); PG8_WAIT_L(0); PG8_BAR; PG8_MMA(0, 0, At, B0); PG8_MMA(0, 1, At, B1); PG8_BAR; PG8_SCHED;
            PG8_LDA(At, 0, 1); PG8_STAGE(PG8_SB(0, 0), b2, voffB); PG8_STAGE(PG8_SB(0, 1), b2 + hstep, voffB); PG8_STAGE(PG8_SA(0, 0), a2, vo2[0]);
            PG8_WAIT_V(8); PG8_WAIT_L(0); PG8_BAR; PG8_MMA(1, 0, At, B0); PG8_MMA(1, 1, At, B1); PG8_BAR; PG8_SCHED;
            PG8_LDB(B0, 1, 0); PG8_LDB(B1, 1, 1); PG8_SCHED; PG8_LDA(At, 1, 0); PG8_STAGE(PG8_SA(0, 1), a2, vo2[1]);
            PG8_WAIT_V(8); PG8_WAIT_L(0); PG8_BAR; PG8_MMA(0, 0, At, B0); PG8_MMA(0, 1, At, B1); PG8_BAR; PG8_SCHED;
            PG8_LDA(At, 1, 1); PG8_STAGE(PG8_SB(1, 0), b3, voffB); PG8_STAGE(PG8_SB(1, 1), b3 + hstep, voffB); PG8_STAGE(PG8_SA(1, 0), a3, vo2[0]);
            PG8_WAIT_V(8); PG8_WAIT_L(0); PG8_BAR; PG8_MMA(1, 0, At, B0); PG8_MMA(1, 1, At, B1); PG8_BAR; PG8_SCHED;
        }
        if constexpr (ALIGN_EPI) { if (wr == 0) PG8_BAR; }
        E(acc, cur, wr, wc, fr, fq);
        if (!has_next) break;
#pragma unroll
        for (int a = 0; a < 2; ++a)
#pragma unroll
            for (int b = 0; b < 2; ++b)
#pragma unroll
                for (int m = 0; m < 4; ++m)
#pragma unroll
                    for (int n = 0; n < 2; ++n) acc[a][b][m][n] = (f32x4){0.f, 0.f, 0.f, 0.f};
        cur = nxt; cA = nA; cB = nB; ++ui;
#pragma unroll
        for (int _h = 0; _h < 2; ++_h)
#pragma unroll
            for (int _i = 0; _i < 2; ++_i) voA[_h][_i] = voN[_h][_i];
        if constexpr (ALIGN_EPI) { if (wr == 1) PG8_BAR; }
    }
    PG8_WAIT_V(0);
    if constexpr (!ALIGN_EPI) { if (wr == 0) PG8_BAR; }
    PG8_BAR;
#undef PG8_SA
#undef PG8_SB
#undef PG8_STAGE
#undef PG8_LDA
#undef PG8_LDB
#undef PG8_MMA
#undef PG8_WAIT_V
#undef PG8_WAIT_L
#undef PG8_BAR
#undef PG8_SCHED
#undef PG8_VOA
}
}

namespace att {
typedef short v4i16 __attribute__((ext_vector_type(4)));
__device__ __forceinline__ int crow(int r, int hi) { return (r & 3) + 8 * (r >> 2) + 4 * hi; }
__device__ __forceinline__ bf16x8 vtr2(const LAS unsigned char* p) {
    const v4i16 lo = __builtin_amdgcn_ds_read_tr16_b64_v4i16((LAS v4i16*)p), hi = __builtin_amdgcn_ds_read_tr16_b64_v4i16((LAS v4i16*)(p + 512));
    return (bf16x8){lo[0], lo[1], lo[2], lo[3], hi[0], hi[1], hi[2], hi[3]};
}
__device__ __forceinline__ bf16x8 pack8(const f32x16& p, int b) {
    u32x4 w; w.x = cvt_pk_bf16(p[b], p[b + 1]); w.y = cvt_pk_bf16(p[b + 2], p[b + 3]); w.z = cvt_pk_bf16(p[b + 4], p[b + 5]); w.w = cvt_pk_bf16(p[b + 6], p[b + 7]);
    return __builtin_bit_cast(bf16x8, w);
}
__device__ __forceinline__ float swapmax(float v) { auto rr = __builtin_amdgcn_permlane32_swap(__float_as_uint(v), __float_as_uint(v), false, false); return fmaxf(__uint_as_float(rr[0]), __uint_as_float(rr[1])); }
__device__ __forceinline__ float swapsum(float v) { auto rr = __builtin_amdgcn_permlane32_swap(__float_as_uint(v), __float_as_uint(v), false, false); return __uint_as_float(rr[0]) + __uint_as_float(rr[1]); }
__device__ __forceinline__ float swapother(float v, int hi) { auto rr = __builtin_amdgcn_permlane32_swap(__float_as_uint(v), __float_as_uint(v), false, false); return hi ? __uint_as_float(rr[0]) : __uint_as_float(rr[1]); }
#ifdef DBG_NO_DMA
#define GLDS16(g, l) (*(LAS u32x4*)((l) + (threadIdx.x & 63) * 16) = *(const u32x4*)(g))
#else
#define GLDS16(g, l) __builtin_amdgcn_global_load_lds((const unsigned*)(g), (LAS unsigned*)(l), 16, 0, 0)
#endif

constexpr float DA_THR = 8.f;
__device__ __forceinline__ void da_unit(LAS unsigned char* lds, const bf16_t* proj, bf16_t* mix, int b, int h, int qb, float lam, const float* gainp) {
    const int tid = threadIdx.x, lane = tid & 63, wid = __builtin_amdgcn_readfirstlane(tid >> 6), r32 = lane & 31, hi = lane >> 5;
    const int rg = wid & 3, c = wid >> 2;
    const size_t rowbase = (size_t)b * T_;
    const int i0w = qb * 128 + rg * 32;
    const float slope2 = exp2f(-2.f * (float)(h + 1)) * LOG2E;
    LAS float* wsf = (LAS float*)(lds + 65536) + wid * 64;
    bf16x8 qf[4];
    { const bf16_t* qp = proj + (rowbase + i0w + r32) * P0 + h * 128 + c * 64 + hi * 8;
#pragma unroll
      for (int s = 0; s < 4; ++s) qf[s] = *(const bf16x8*)(qp + s * 16); }
    f32x16 o[4];
#pragma unroll
    for (int d = 0; d < 4; ++d)
#pragma unroll
        for (int r = 0; r < 16; ++r) o[d][r] = 0.f;
    float mrun = -1e30f, lrun = 0.f;
    const int nt = 2 * qb + 2;
    const bf16_t* ksrc[2]; const bf16_t* vsrc[2];
    { const int key = tid >> 3, chp = tid & 7;
#pragma unroll
      for (int i = 0; i < 2; ++i) ksrc[i] = proj + (rowbase + key) * P0 + 512 + h * 128 + i * 64 + ((chp ^ (key & 7)) * 8);
      const int ks = (tid >> 6) & 3, sub = (tid >> 5) & 1, row = (tid >> 2) & 7, cq = tid & 3, vkey = ks * 16 + sub * 8 + row;
#pragma unroll
      for (int i = 0; i < 2; ++i) vsrc[i] = proj + (rowbase + vkey) * P0 + 1024 + h * 128 + (i * 2 + (tid >> 8)) * 32 + cq * 8; }
    const unsigned ldsw = (unsigned)wid * 1024u;
#define DA_ISSUE(jt, sb) do { const size_t _o = (size_t)(jt) * 64 * P0; \
        GLDS16(ksrc[0] + _o, lds + (sb) * 32768 + ldsw); GLDS16(ksrc[1] + _o, lds + (sb) * 32768 + 8192 + ldsw); \
        GLDS16(vsrc[0] + _o, lds + (sb) * 32768 + 16384 + ldsw); GLDS16(vsrc[1] + _o, lds + (sb) * 32768 + 24576 + ldsw); } while (0)
    const int koff = c * 8192 + r32 * 128, kx = r32 & 7;
    const int voff = 16384 + ((lane >> 4) & 1) * 32 + (lane & 3) * 8 + (4 * hi + ((lane & 15) >> 2)) * 64;
    DA_ISSUE(nt - 1, 0);
    __syncthreads();
    for (int it = 0; it < nt; ++it) {
        const int jt = nt - 1 - it, sb = it & 1;
        if (it + 1 < nt) DA_ISSUE(jt - 1, sb ^ 1);
        const int j0 = jt * 64, dj = j0 - i0w;
        if (dj <= 31) {
            const LAS unsigned char* kb = lds + sb * 32768 + koff;
            f32x16 p0, p1;
            const float bbase = slope2 * (float)(dj + 4 * hi);
#pragma unroll
            for (int r = 0; r < 16; ++r) { p0[r] = fmaf(slope2, (float)((r & 3) + 8 * (r >> 2)), bbase); p1[r] = p0[r] + 32.f * slope2; }
#pragma unroll
            for (int s = 0; s < 4; ++s) {
                const bf16x8 ka = *(const LAS bf16x8*)(kb + (((2 * s + hi) ^ kx) << 4));
                const bf16x8 kb2 = *(const LAS bf16x8*)(kb + 4096 + (((2 * s + hi) ^ kx) << 4));
                p0 = __builtin_amdgcn_mfma_f32_32x32x16_bf16(ka, qf[s], p0, 0, 0, 0);
                p1 = __builtin_amdgcn_mfma_f32_32x32x16_bf16(kb2, qf[s], p1, 0, 0, 0);
            }
            if (dj + 63 > 0) {
#pragma unroll
                for (int r = 0; r < 16; ++r) { const int kk = dj + (r & 3) + 8 * (r >> 2) + 4 * hi; if (kk > r32) p0[r] = -INFINITY; if (kk + 32 > r32) p1[r] = -INFINITY; }
            }
            float mx = fmaxf(p0[0], p1[0]);
#pragma unroll
            for (int r = 1; r < 16; ++r) mx = fmaxf(mx, fmaxf(p0[r], p1[r]));
            mx = swapmax(mx);
            if (__any(mx > mrun + DA_THR)) {
                const float mn = fmaxf(mrun, mx), f = fexp2(mrun - mn);
                lrun *= f; mrun = mn;
                if (hi == 0) wsf[r32] = f;
#pragma unroll
                for (int r = 0; r < 16; ++r) { const float fr = wsf[crow(r, hi)];
#pragma unroll
                    for (int d = 0; d < 4; ++d) o[d][r] *= fr; }
            }
            float sum = 0.f;
#pragma unroll
            for (int r = 0; r < 16; ++r) { p0[r] = fexp2(p0[r] - mrun); p1[r] = fexp2(p1[r] - mrun); sum += p0[r] + p1[r]; }
            lrun += sum;
            bf16x8 pa[4];
            pa[0] = pack8(p0, 0); pa[1] = pack8(p0, 8); pa[2] = pack8(p1, 0); pa[3] = pack8(p1, 8);
            const LAS unsigned char* vb = lds + sb * 32768 + voff;
#pragma unroll
            for (int d = 0; d < 4; ++d)
#pragma unroll
                for (int s = 0; s < 4; ++s) { const bf16x8 vf = vtr2(vb + d * 4096 + s * 1024);
                    o[d] = __builtin_amdgcn_mfma_f32_32x32x16_bf16(pa[s], vf, o[d], 0, 0, 0); }
        }
        __syncthreads();
    }
#undef DA_ISSUE
    const float lt = swapsum(lrun);
    if (hi == 0) wsf[r32] = (c == 0 ? 1.f : lam) / lt;
    LAS float* xch = (LAS float*)lds + rg * 4096 + lane;
#pragma unroll
    for (int r = 0; r < 16; ++r) { const float cf = wsf[crow(r, hi)];
#pragma unroll
        for (int d = 0; d < 4; ++d) { o[d][r] *= cf; if (c == 1) xch[(d * 16 + r) * 64] = o[d][r]; } }
    __syncthreads();
    if (c == 0) {
        float ssq[16];
#pragma unroll
        for (int r = 0; r < 16; ++r) { float q = 0.f;
#pragma unroll
            for (int d = 0; d < 4; ++d) { const float v = o[d][r] - xch[(d * 16 + r) * 64]; o[d][r] = v; q += v * v; }
            ssq[r] = q; }
#pragma unroll
        for (int r = 0; r < 16; ++r) {
#pragma unroll
            for (int off = 1; off < 32; off <<= 1) ssq[r] += __shfl_xor(ssq[r], off);
            ssq[r] = (1.f - LAM_INIT0) / sqrtf(ssq[r] * (1.f / 128.f) + RMS_EPS); }
        float gn[4];
#pragma unroll
        for (int d = 0; d < 4; ++d) gn[d] = gainp[d * 32 + r32];
#pragma unroll
        for (int r = 0; r < 16; ++r) { bf16_t* orow = mix + (rowbase + i0w + crow(r, hi)) * D_ + h * 128 + r32;
#pragma unroll
            for (int d = 0; d < 4; ++d) orow[d * 32] = f2bf(o[d][r] * ssq[r] * gn[d]); }
    }
    __syncthreads();
}
__device__ __forceinline__ void ph_diffattn(const Ptrs& P, LAS unsigned char* lds, int vcu, int G) {
    const int lane = threadIdx.x & 63;
    const float* dl = P.in[8];
    const float d01 = wave_sum(dl[lane] * dl[64 + lane]), d23 = wave_sum(dl[128 + lane] * dl[192 + lane]);
    const float lam = expf(d01) - expf(d23) + LAM_INIT0;
    for (int u = vcu; u < 256; u += G) {
        const int bh = u >> 3, s = u & 7;
        for (int k = 0; k < 4; ++k) { const int qb = (k == 0) ? s : (k == 1) ? 15 - s : (k == 2) ? 16 + s : 31 - s;
            da_unit(lds, (const bf16_t*)(P.ws + WS_P), (bf16_t*)(P.ws + WS_H), bh >> 2, bh & 3, qb, lam, P.in[9]); }
    }
}

#ifndef SB_EXIT
#define SB_EXIT 1e-30f
#endif
__device__ __forceinline__ void sb_unit(LAS unsigned char* lds, const bf16_t* proj, bf16_t* mix, int b, int h, int qb) {
    const int tid = threadIdx.x, lane = tid & 63, wid = __builtin_amdgcn_readfirstlane(tid >> 6), r32 = lane & 31, hi = lane >> 5;
    const size_t rowbase = (size_t)b * T_;
    const int i0w = qb * 256 + wid * 32;
    LAS float* flg = (LAS float*)(lds + 32768);
    bf16x8 qf[4];
    { const bf16_t* qp = proj + (rowbase + i0w + r32) * P1 + 1024 + h * 64 + hi * 8;
#pragma unroll
      for (int s = 0; s < 4; ++s) qf[s] = *(const bf16x8*)(qp + s * 16); }
    f32x16 o[2];
#pragma unroll
    for (int d = 0; d < 2; ++d)
#pragma unroll
        for (int r = 0; r < 16; ++r) o[d][r] = 0.f;
    float Rrun = 1.f;
    const int nt = 4 * qb + 4;
    const bf16_t* ksrc; const bf16_t* vsrc;
    { const int key = tid >> 3, chp = tid & 7;
      ksrc = proj + (rowbase + key) * P1 + 1536 + h * 64 + ((chp ^ (key & 7)) * 8);
      const int ks = (tid >> 6) & 3, sub = (tid >> 5) & 1, row = (tid >> 2) & 7, cq = tid & 3, vkey = ks * 16 + sub * 8 + row;
      vsrc = proj + (rowbase + vkey) * P1 + 2048 + h * 64 + (tid >> 8) * 32 + cq * 8; }
    const unsigned ldsw = (unsigned)wid * 1024u;
#define SB_ISSUE(jt, sb) do { const size_t _o = (size_t)(jt) * 64 * P1; GLDS16(ksrc + _o, lds + (sb) * 16384 + ldsw); GLDS16(vsrc + _o, lds + (sb) * 16384 + 8192 + ldsw); } while (0)
    const int koff = r32 * 128, kx = r32 & 7;
    const int voff = 8192 + ((lane >> 4) & 1) * 32 + (lane & 3) * 8 + (4 * hi + ((lane & 15) >> 2)) * 64;
    SB_ISSUE(nt - 1, 0);
    __syncthreads();
    for (int it = 0; it < nt; ++it) {
        const int jt = nt - 1 - it, sb = it & 1;
        if (it + 1 < nt) SB_ISSUE(jt - 1, sb ^ 1);
        const int j0 = jt * 64, dj = j0 - i0w;
        if (dj <= 30) {
            const LAS unsigned char* kb = lds + sb * 16384 + koff;
            f32x16 p0, p1;
#pragma unroll
            for (int r = 0; r < 16; ++r) { p0[r] = 0.f; p1[r] = 0.f; }
#pragma unroll
            for (int s = 0; s < 4; ++s) {
                const bf16x8 ka = *(const LAS bf16x8*)(kb + (((2 * s + hi) ^ kx) << 4));
                const bf16x8 kb2 = *(const LAS bf16x8*)(kb + 4096 + (((2 * s + hi) ^ kx) << 4));
                p0 = __builtin_amdgcn_mfma_f32_32x32x16_bf16(ka, qf[s], p0, 0, 0, 0);
                p1 = __builtin_amdgcn_mfma_f32_32x32x16_bf16(kb2, qf[s], p1, 0, 0, 0);
            }
            f32x16 q0, q1;
#pragma unroll
            for (int r = 0; r < 16; ++r) {
                const float e0 = fexp2(fminf(p0[r], 80.f)), e1 = fexp2(fminf(p1[r], 80.f));
                q0[r] = frcp(1.f + e0); q1[r] = frcp(1.f + e1); p0[r] = e0 * q0[r]; p1[r] = e1 * q1[r]; }
            if (dj + 63 >= 0) {
#pragma unroll
                for (int r = 0; r < 16; ++r) { const int kk = dj + (r & 3) + 8 * (r >> 2) + 4 * hi;
                    if (kk >= r32) { p0[r] = 0.f; q0[r] = 1.f; } if (kk + 32 >= r32) { p1[r] = 0.f; q1[r] = 1.f; } }
            }
            float Gown[8], Goth[8], Tsuf[8];
#pragma unroll
            for (int g = 0; g < 4; ++g) { Gown[g] = (q0[4 * g] * q0[4 * g + 1]) * (q0[4 * g + 2] * q0[4 * g + 3]); Gown[4 + g] = (q1[4 * g] * q1[4 * g + 1]) * (q1[4 * g + 2] * q1[4 * g + 3]); }
#pragma unroll
            for (int g = 0; g < 8; ++g) Goth[g] = swapother(Gown[g], hi);
            Tsuf[7] = 1.f;
#pragma unroll
            for (int g = 6; g >= 0; --g) Tsuf[g] = Tsuf[g + 1] * (Gown[g + 1] * Goth[g + 1]);
            const float tot = Tsuf[0] * (Gown[0] * Goth[0]);
#pragma unroll
            for (int g = 0; g < 4; ++g) {
                const float f0 = Rrun * Tsuf[g] * (hi ? 1.f : Goth[g]), f1 = Rrun * Tsuf[4 + g] * (hi ? 1.f : Goth[4 + g]);
                const float a3 = q0[4 * g + 3], a2 = a3 * q0[4 * g + 2], a1 = a2 * q0[4 * g + 1];
                p0[4 * g + 3] *= f0; p0[4 * g + 2] *= f0 * a3; p0[4 * g + 1] *= f0 * a2; p0[4 * g] *= f0 * a1;
                const float b3 = q1[4 * g + 3], b2 = b3 * q1[4 * g + 2], b1 = b2 * q1[4 * g + 1];
                p1[4 * g + 3] *= f1; p1[4 * g + 2] *= f1 * b3; p1[4 * g + 1] *= f1 * b2; p1[4 * g] *= f1 * b1;
            }
            Rrun *= tot;
            bf16x8 pa[4];
            pa[0] = pack8(p0, 0); pa[1] = pack8(p0, 8); pa[2] = pack8(p1, 0); pa[3] = pack8(p1, 8);
            const LAS unsigned char* vb = lds + sb * 16384 + voff;
#pragma unroll
            for (int d = 0; d < 2; ++d)
#pragma unroll
                for (int s = 0; s < 4; ++s) { const bf16x8 vf = vtr2(vb + d * 4096 + s * 1024);
                    o[d] = __builtin_amdgcn_mfma_f32_32x32x16_bf16(pa[s], vf, o[d], 0, 0, 0); }
        }
        { const float wm = wave_max(Rrun); if (lane == 0) flg[sb * 8 + wid] = wm; }
        __syncthreads();
        { float mxr = flg[sb * 8];
#pragma unroll
          for (int w = 1; w < 8; ++w) mxr = fmaxf(mxr, flg[sb * 8 + w]);
          if (mxr < SB_EXIT) break; }
    }
#undef SB_ISSUE
    __syncthreads();
#pragma unroll
    for (int r = 0; r < 16; ++r) { bf16_t* orow = mix + (rowbase + i0w + crow(r, hi)) * D_ + 512 + h * 64 + r32;
#pragma unroll
        for (int d = 0; d < 2; ++d) orow[d * 32] = f2bf(o[d][r]); }
}
__device__ __forceinline__ void ph_sbattn(const Ptrs& P, LAS unsigned char* lds, int vcu, int G) {
    for (int u = vcu; u < 256; u += G) {
        const int bh = u >> 2, s = u & 3;
        for (int k = 0; k < 4; ++k) { const int qb = (k == 0) ? s : (k == 1) ? 7 - s : (k == 2) ? 8 + s : 15 - s;
            sb_unit(lds, (const bf16_t*)(P.ws + WS_P), (bf16_t*)(P.ws + WS_H), bh >> 3, bh & 7, qb); }
    }
}
}

namespace hg {
constexpr int QM = 0, KM = 17408, QB = 34816, KDT = 52224, VT = 70656, ATT = 89088, DEC = 98304, TOT = 98816, OO = 0;
constexpr int PQ = 272, PT = 144, PO = 528;
typedef float f32x4v __attribute__((ext_vector_type(4)));
__device__ __forceinline__ f32x4 mma16(bf16x8 a, bf16x8 b, f32x4 c) { return __builtin_amdgcn_mfma_f32_16x16x32_bf16(a, b, c, 0, 0, 0); }
template <bool STATS>
__device__ __forceinline__ void hg_unit(LAS unsigned char* lds, const Ptrs& P, int u) {
    const int tid = threadIdx.x, lane = tid & 63, wid = __builtin_amdgcn_readfirstlane(tid >> 6), l15 = lane & 15, g = lane >> 4;
    const int bh = u >> 3, seg = u & 7, b = bh >> 2, h = bh & 3;
    const bf16_t* proj = (const bf16_t*)(P.ws + WS_P);
    bf16_t* mix = (bf16_t*)(P.ws + WS_H);
    float* HGS = (float*)(P.ws + WS_HGS); float* HGD = (float*)(P.ws + WS_HGD);
    const int col = tid & 127, qtr = tid >> 7;
    float lb;
    { const float* gam = P.in[10]; const int c = h * 128 + col; const float g0 = gam[c], g1 = gam[512 + c], g2 = gam[1024 + c]; const float mx = fmaxf(g0, fmaxf(g1, g2));
      const float e0 = expf(g0 - mx), e1 = expf(g1 - mx), e2 = expf(g2 - mx); lb = e0 / (e0 + e1 + e2); }
    f32x4 S[8];
#pragma unroll
    for (int k = 0; k < 8; ++k) S[k] = (f32x4){0.f, 0.f, 0.f, 0.f};
    if (!STATS) {
        for (int j = 0; j < seg; ++j) { const int uj = bh * 8 + j;
            const f32x4* sp = (const f32x4*)(HGS + (size_t)uj * 16384) + (wid * 8) * 64 + lane; const float* dp = HGD + (size_t)uj * 128;
#pragma unroll
            for (int k = 0; k < 8; ++k) { const f32x4 d = *(const f32x4*)(dp + 16 * k + 4 * g); S[k] = S[k] * d + sp[k * 64]; } }
    }
    float sumlog = 0.f;
    for (int ch = 0; ch < 8; ++ch) {
        const size_t row0 = (size_t)b * T_ + seg * 512 + ch * 64 + qtr * 16;
        float cs[16], kk[16], qv[16], vv[16];
        { const bf16_t* pr = proj + row0 * P0 + h * 128 + col; float run = 0.f;
#pragma unroll
          for (int i = 0; i < 16; ++i) { const bf16_t* r = pr + (size_t)i * P0;
              const float fl = bf2f(r[2048]); const float f = lb + (1.f - lb) * sigmoidf_(fl);
              run += __builtin_amdgcn_logf(f) * LN2F; cs[i] = run; kk[i] = 1.f - f; vv[i] = bf2f(r[2560]); if (!STATS) qv[i] = bf2f(r[1536]); } }
        ((LAS float*)(lds + TOT))[qtr * 128 + col] = cs[15];
        __syncthreads();
        { const LAS float* tp = (const LAS float*)(lds + TOT) + col; const float t0 = tp[0], t1 = tp[128], t2 = tp[256], t3 = tp[384];
          const float off = (qtr > 0 ? t0 : 0.f) + (qtr > 1 ? t1 : 0.f) + (qtr > 2 ? t2 : 0.f), bmid = t0 + t1, blast = (t0 + t1) + (t2 + t3);
          const float emid = fexp(bmid), elm = fexp(blast - bmid);
          if (qtr == 0) { ((LAS float*)(lds + DEC))[col] = fexp(blast); sumlog += blast; }
#pragma unroll
          for (int i = 0; i < 16; ++i) { const int tok = qtr * 16 + i; const float bb = cs[i] + off; const float e1 = fexp(bb - bmid), e2 = frcp(e1);
              *(LAS bf16_t*)(lds + KDT + col * PT + tok * 2) = f2bf(kk[i] * e2 * elm);
              *(LAS bf16_t*)(lds + VT + col * PT + tok * 2) = f2bf(vv[i]);
              if (!STATS) { *(LAS bf16_t*)(lds + QM + tok * PQ + col * 2) = f2bf(qv[i] * e1); *(LAS bf16_t*)(lds + KM + tok * PQ + col * 2) = f2bf(kk[i] * e2);
                  *(LAS bf16_t*)(lds + QB + tok * PQ + col * 2) = f2bf(qv[i] * e1 * emid); } } }
        __syncthreads();
        f32x4 ao[4];
        if (!STATS) {
#pragma unroll
            for (int rep = 0; rep < 2; ++rep) { const int ti = wid + 8 * rep;
                if (ti < 10) { const int cb = ti < 1 ? 0 : ti < 3 ? 1 : ti < 6 ? 2 : 3; const int sb = ti - (cb * (cb + 1)) / 2;
                    f32x4 acc = (f32x4){0.f, 0.f, 0.f, 0.f};
#pragma unroll
                    for (int st = 0; st < 4; ++st) { const bf16x8 a = *(const LAS bf16x8*)(lds + QM + (16 * cb + l15) * PQ + (32 * st + 8 * g) * 2), bb = *(const LAS bf16x8*)(lds + KM + (16 * sb + l15) * PQ + (32 * st + 8 * g) * 2);
                        acc = mma16(a, bb, acc); }
#pragma unroll
                    for (int r = 0; r < 4; ++r) { float v = acc[r]; if (cb == sb && 4 * g + r < l15) v = 0.f; *(LAS bf16_t*)(lds + ATT + (16 * cb + 4 * g + r) * PT + (16 * sb + l15) * 2) = f2bf(v); } }
                else if (rep == 1 && wid >= 2) { const int zi = wid - 2; const int cb = zi < 3 ? 0 : zi < 5 ? 1 : 2; const int sb = zi < 3 ? zi + 1 : zi < 5 ? zi - 1 : 3;
#pragma unroll
                    for (int r = 0; r < 4; ++r) *(LAS bf16_t*)(lds + ATT + (16 * cb + 4 * g + r) * PT + (16 * sb + l15) * 2) = 0; } }
            bf16x8 Sb[4];
#pragma unroll
            for (int st = 0; st < 4; ++st) { u32x4 w; w.x = cvt_pk_bf16(S[2 * st][0], S[2 * st][1]); w.y = cvt_pk_bf16(S[2 * st][2], S[2 * st][3]); w.z = cvt_pk_bf16(S[2 * st + 1][0], S[2 * st + 1][1]); w.w = cvt_pk_bf16(S[2 * st + 1][2], S[2 * st + 1][3]); Sb[st] = __builtin_bit_cast(bf16x8, w); }
#pragma unroll
            for (int cb = 0; cb < 4; ++cb) { ao[cb] = (f32x4){0.f, 0.f, 0.f, 0.f};
#pragma unroll
                for (int st = 0; st < 4; ++st) { const LAS unsigned char* ap = lds + QB + (16 * cb + l15) * PQ + (32 * st + 4 * g) * 2;
                    const u32x2 lo = *(const LAS u32x2*)ap, hi2 = *(const LAS u32x2*)(ap + 32); const u32x4 w = {lo.x, lo.y, hi2.x, hi2.y};
                    ao[cb] = mma16(__builtin_bit_cast(bf16x8, w), Sb[st], ao[cb]); } }
        }
#pragma unroll
        for (int k = 0; k < 8; ++k) { const f32x4 d = *(const LAS f32x4*)(lds + DEC + (16 * k + 4 * g) * 4); S[k] = S[k] * d;
#pragma unroll
            for (int ks = 0; ks < 2; ++ks) { const bf16x8 a = *(const LAS bf16x8*)(lds + KDT + (16 * k + l15) * PT + (32 * ks + 8 * g) * 2), bb = *(const LAS bf16x8*)(lds + VT + (16 * wid + l15) * PT + (32 * ks + 8 * g) * 2);
                S[k] = mma16(a, bb, S[k]); } }
        __syncthreads();
        if (!STATS) {
#pragma unroll
            for (int cb = 0; cb < 4; ++cb)
#pragma unroll
                for (int ks = 0; ks < 2; ++ks) { const bf16x8 a = *(const LAS bf16x8*)(lds + ATT + (16 * cb + l15) * PT + (32 * ks + 8 * g) * 2), bb = *(const LAS bf16x8*)(lds + VT + (16 * wid + l15) * PT + (32 * ks + 8 * g) * 2);
                    ao[cb] = mma16(a, bb, ao[cb]); }
#pragma unroll
            for (int cb = 0; cb < 4; ++cb)
#pragma unroll
                for (int r = 0; r < 4; ++r) *(LAS float*)(lds + OO + (16 * cb + 4 * g + r) * PO + (16 * wid + l15) * 4) = ao[cb][r];
            __syncthreads();
            { const int row = tid >> 3, sg = tid & 7; const LAS f32x4* op = (const LAS f32x4*)(lds + OO + row * PO + sg * 64);
              f32x4 v[4]; float q = 0.f;
#pragma unroll
              for (int i = 0; i < 4; ++i) { v[i] = op[i]; q += (v[i][0] * v[i][0] + v[i][1] * v[i][1]) + (v[i][2] * v[i][2] + v[i][3] * v[i][3]); }
              q += __shfl_xor(q, 1); q += __shfl_xor(q, 2); q += __shfl_xor(q, 4);
              const float rstd = 1.f / sqrtf(q * (1.f / 128.f) + RMS_EPS);
              const size_t grow = (size_t)b * T_ + seg * 512 + ch * 64 + row;
              const bf16_t* gp = proj + grow * P0 + 3072 + h * 128 + sg * 16; const float* gn = P.in[11] + sg * 16;
              const u32x4 ga = *(const u32x4*)gp, gb = *(const u32x4*)(gp + 8);
              const unsigned gw[8] = {ga.x, ga.y, ga.z, ga.w, gb.x, gb.y, gb.z, gb.w};
              unsigned ow[8];
#pragma unroll
              for (int i = 0; i < 8; ++i) { const float x0 = v[i >> 1][(i & 1) * 2] * rstd * gn[2 * i] * __uint_as_float(gw[i] << 16), x1 = v[i >> 1][(i & 1) * 2 + 1] * rstd * gn[2 * i + 1] * __uint_as_float(gw[i] & 0xffff0000u);
                  ow[i] = cvt_pk_bf16(x0, x1); }
              bf16_t* mp = mix + grow * D_ + 512 + h * 128 + sg * 16;
              *(u32x4*)mp = (u32x4){ow[0], ow[1], ow[2], ow[3]}; *(u32x4*)(mp + 8) = (u32x4){ow[4], ow[5], ow[6], ow[7]}; }
            __syncthreads();
        }
    }
    if (STATS) {
        f32x4* sp = (f32x4*)(HGS + (size_t)u * 16384) + (wid * 8) * 64 + lane;
#pragma unroll
        for (int k = 0; k < 8; ++k) sp[k * 64] = S[k];
        if (qtr == 0) HGD[(size_t)u * 128 + col] = fexp(sumlog);
    }
}
template <bool STATS>
__device__ __forceinline__ void ph_hgrn(const Ptrs& P, LAS unsigned char* lds, int vcu, int G) {
    for (int u = vcu; u < 256; u += G) { hg_unit<STATS>(lds, P, u); __syncthreads(); }
}
}

namespace lru {
constexpr int XR = 0, XCB = 16896, WG = 35328, AL = 53760, UL = 86528, PS = 119296, HS = 121344, HC = 123392, PC = 123648;
constexpr int PX = 144;
template <bool STATS>
__device__ __forceinline__ void lru_unit(LAS unsigned char* lds, const Ptrs& P, int u) {
    const int tid = threadIdx.x, lane = tid & 63, wid = __builtin_amdgcn_readfirstlane(tid >> 6), r32 = lane & 31, hi = lane >> 5;
    const int b = u >> 5, g = (u >> 2) & 7, q = u & 3;
    const bf16_t* proj = (const bf16_t*)(P.ws + WS_P);
    bf16_t* mix = (bf16_t*)(P.ws + WS_H);
    float* ST = (float*)(P.ws + WS_LRU);
    for (int idx = tid; idx < 8192; idx += 512) { const int k = idx >> 7, n = idx & 127;
        const float w = n < 64 ? P.in[16][(size_t)(g * 64 + k) * 64 + n] : P.in[18][(size_t)(g * 64 + k) * 64 + (n - 64)];
        *(LAS bf16_t*)(lds + WG + n * PX + k * 2) = f2bf(w); }
    const int ch = tid & 63, oct = tid >> 6, cg = g * 64 + ch;
    const float w0 = P.in[14][cg], w1 = P.in[14][512 + cg], w2 = P.in[14][1024 + cg], w3 = P.in[14][1536 + cg], cbv = P.in[15][cg];
    const int tb = wid >> 1, chh = wid & 1, chm = chh * 32 + r32, cgm = g * 64 + chm;
    const float bav = P.in[17][cgm], bxv = P.in[19][cgm], spv = softplusf_(-P.in[20][cgm]);
    if (tid < 64) { float c = 0.f;
        if (!STATS) { for (int qq = 0; qq < q; ++qq) { const float* sp = ST + ((size_t)(b * 4 + qq) * 512 + cg) * 2; c = sp[0] * c + sp[1]; } }
        ((LAS float*)(lds + HC))[ch] = c; ((LAS float*)(lds + PC))[ch] = 1.f; }
    __syncthreads();
    for (int sbk = 0; sbk < 8; ++sbk) {
        const int t0 = q * 1024 + sbk * 128;
        for (int idx = tid; idx < 131 * 8; idx += 512) { const int r = idx >> 3, c8 = idx & 7; const int t = t0 - 3 + r;
            u32x4 v = {0u, 0u, 0u, 0u}; if (t >= 0) v = *(const u32x4*)(proj + ((size_t)b * T_ + t) * P1 + g * 64 + c8 * 8);
            *(LAS u32x4*)(lds + XR + r * 128 + c8 * 16) = v; }
        __syncthreads();
#pragma unroll 4
        for (int i = 0; i < 16; ++i) { const int tl = oct * 16 + i; const LAS bf16_t* xp = (const LAS bf16_t*)(lds + XR) + tl * 64 + ch;
            const float xc = w0 * bf2f(xp[0]) + w1 * bf2f(xp[64]) + w2 * bf2f(xp[128]) + w3 * bf2f(xp[192]) + cbv;
            *(LAS bf16_t*)(lds + XCB + tl * PX + ch * 2) = f2bf(xc); }
        __syncthreads();
        { f32x16 ga, gx;
#pragma unroll
          for (int r = 0; r < 16; ++r) { ga[r] = 0.f; gx[r] = 0.f; }
#pragma unroll
          for (int s = 0; s < 4; ++s) { const bf16x8 a = *(const LAS bf16x8*)(lds + XCB + (32 * tb + r32) * PX + (16 * s + 8 * hi) * 2);
              const bf16x8 ba_ = *(const LAS bf16x8*)(lds + WG + chm * PX + (16 * s + 8 * hi) * 2), bx_ = *(const LAS bf16x8*)(lds + WG + (64 + chm) * PX + (16 * s + 8 * hi) * 2);
              ga = __builtin_amdgcn_mfma_f32_32x32x16_bf16(a, ba_, ga, 0, 0, 0); gx = __builtin_amdgcn_mfma_f32_32x32x16_bf16(a, bx_, gx, 0, 0, 0); }
#pragma unroll
          for (int r = 0; r < 16; ++r) { const int t = 32 * tb + (r & 3) + 8 * (r >> 2) + 4 * hi;
              const float xcv = bf2f(*(const LAS bf16_t*)(lds + XCB + t * PX + chm * 2));
              const float rg = sigmoidf_(ga[r] + bav), ig = sigmoidf_(gx[r] + bxv);
              const float la = -8.f * rg * spv, a = fexp(la), x2 = 2.f * la;
              const float om = (x2 > -0.25f) ? -x2 * (1.f + 0.5f * x2 * (1.f + (1.f / 3.f) * x2 * (1.f + 0.25f * x2 * (1.f + 0.2f * x2)))) : 1.f - a * a;
              const float uu = sqrtf(fmaxf(om, 1e-12f)) * (ig * xcv);
              ((LAS float*)(lds + AL))[t * 64 + chm] = a; ((LAS float*)(lds + UL))[t * 64 + chm] = uu; } }
        __syncthreads();
        { float hl = 0.f, pl = 1.f; LAS float* ap = (LAS float*)(lds + AL) + (oct * 16) * 64 + ch; LAS float* up = (LAS float*)(lds + UL) + (oct * 16) * 64 + ch;
#pragma unroll 4
          for (int i = 0; i < 16; ++i) { const float a = ap[i * 64], uu = up[i * 64]; hl = a * hl + uu; pl *= a; up[i * 64] = hl; ap[i * 64] = pl; }
          ((LAS float*)(lds + PS))[oct * 64 + ch] = pl; ((LAS float*)(lds + HS))[oct * 64 + ch] = hl; }
        __syncthreads();
        { float c = ((LAS float*)(lds + HC))[ch]; float pt = 1.f;
#pragma unroll
          for (int o = 0; o < 8; ++o) { const float po = ((LAS float*)(lds + PS))[o * 64 + ch], ho = ((LAS float*)(lds + HS))[o * 64 + ch]; if (o < oct) c = po * c + ho; pt *= po; }
          if (!STATS) { const LAS float* ap = (const LAS float*)(lds + AL) + (oct * 16) * 64 + ch; const LAS float* up = (const LAS float*)(lds + UL) + (oct * 16) * 64 + ch;
              const size_t rowb = (size_t)b * T_ + t0 + oct * 16;
#pragma unroll 4
              for (int i = 0; i < 16; ++i) { const float hh = up[i * 64] + ap[i * 64] * c; const float gr = bf2f(proj[(rowb + i) * P1 + 512 + cg]);
                  mix[(rowb + i) * D_ + cg] = f2bf(gr * hh); } }
          __syncthreads();
          if (oct == 7) { const float po = ((LAS float*)(lds + PS))[7 * 64 + ch], ho = ((LAS float*)(lds + HS))[7 * 64 + ch];
              ((LAS float*)(lds + HC))[ch] = po * c + ho; ((LAS float*)(lds + PC))[ch] *= pt; } }
        __syncthreads();
    }
    if (STATS && tid < 64) { float* sp = ST + ((size_t)(b * 4 + q) * 512 + cg) * 2; sp[0] = ((LAS float*)(lds + PC))[ch]; sp[1] = ((LAS float*)(lds + HC))[ch]; }
    __syncthreads();
}
template <bool STATS>
__device__ __forceinline__ void ph_lru(const Ptrs& P, LAS unsigned char* lds, int vcu, int G) {
    for (int u = vcu; u < 256; u += G) lru_unit<STATS>(lds, P, u);
}
}

#define XB_TMO      128
#define XB_XCNT(j)  (256  + 64 * (j))
#define XB_XSUB(j)  (1280 + 64 * (j))
#define XB_XGEN(j)  (2304 + 64 * (j))
#define XB_TOP      3328
#define XB_TOPGEN   3392
#define XCD_BAR_WORDS 3456
#define XB_SPIN_CAP (1u << 18)
__device__ __forceinline__ unsigned xb_ld(unsigned* p)              { return __hip_atomic_load(p, __ATOMIC_RELAXED, __HIP_MEMORY_SCOPE_AGENT); }
__device__ __forceinline__ unsigned xb_add(unsigned* p, unsigned v) { return __hip_atomic_fetch_add(p, v, __ATOMIC_RELAXED, __HIP_MEMORY_SCOPE_AGENT); }
__device__ __forceinline__ unsigned xb_xcc_id() { return (unsigned)__builtin_amdgcn_s_getreg((3 << 11) | 20) & 0xFu; }
#define XB_SPIN(cond, bar) do { unsigned _sp = 0; while (cond) { __builtin_amdgcn_s_sleep(1); \
    if ((++_sp & 255u) == 0u) { if (xb_ld(&(bar)[XB_TMO])) break; if (_sp > XB_SPIN_CAP) { atomicAdd(&(bar)[XB_TMO], 1u); break; } } } } while (0)
struct XcdBarrier { unsigned* bar; unsigned x; volatile LAS unsigned* st; };
__device__ __forceinline__ XcdBarrier xcd_barrier_post(unsigned* bar, volatile LAS unsigned* st) {
    XcdBarrier b; b.bar = bar; b.x = xb_xcc_id(); b.st = st;
    if (threadIdx.x == 0) (void)xb_add(&bar[XB_XCNT(b.x)], 1u);
    return b;
}
__device__ __forceinline__ void xcd_barrier_complete(unsigned* bar, unsigned x, unsigned& nloc, unsigned& nx) {
    const unsigned G = gridDim.x * gridDim.y * gridDim.z;
    unsigned sum, cnt, mine, sp = 0u;
    for (;;) {
        sum = 0u; cnt = 0u; mine = 0u;
#pragma unroll
        for (unsigned j = 0; j < 16; ++j) { const unsigned c = xb_ld(&bar[XB_XCNT(j)]); sum += c; cnt += (c > 0u) ? 1u : 0u; mine = (j == x) ? c : mine; }
        if (sum == G) break;
        __builtin_amdgcn_s_sleep(1);
        if ((++sp & 255u) == 0u) { if (xb_ld(&bar[XB_TMO])) break; if (sp > XB_SPIN_CAP) { atomicAdd(&bar[XB_TMO], 1u); break; } }
    }
    nloc = mine > 0u ? mine : 1u; nx = cnt > 0u ? cnt : 1u;
}
__device__ __forceinline__ void xcd_barrier(const XcdBarrier& b) {
    asm volatile("s_waitcnt vmcnt(0)" ::: "memory");
    __syncthreads();
    if (threadIdx.x == 0) {
        unsigned* bar = b.bar;
        __builtin_amdgcn_s_waitcnt(0);
        unsigned nloc = b.st[0], nx = b.st[1];
        if (nloc == 0u) { xcd_barrier_complete(bar, b.x, nloc, nx); b.st[0] = nloc; b.st[1] = nx; }
        const unsigned old = xb_add(&bar[XB_XSUB(b.x)], 1u);
        const unsigned gen = old / nloc;
        if (old + 1u == (gen + 1u) * nloc) {
            __builtin_amdgcn_fence(__ATOMIC_RELEASE, "agent");
            asm volatile("s_waitcnt vmcnt(0)" ::: "memory");
            const unsigned og = xb_add(&bar[XB_TOP], 1u);
            const unsigned tg = og / nx;
            if (og + 1u == (tg + 1u) * nx) xb_add(&bar[XB_TOPGEN], 1u);
            else XB_SPIN(xb_ld(&bar[XB_TOPGEN]) == tg, bar);
            __builtin_amdgcn_fence(__ATOMIC_ACQUIRE, "agent");
            xb_add(&bar[XB_XGEN(b.x)], 1u);
            asm volatile("s_waitcnt vmcnt(0)" ::: "memory");
        } else {
            XB_SPIN(xb_ld(&bar[XB_XGEN(b.x)]) == gen, bar);
            __builtin_amdgcn_fence(__ATOMIC_ACQUIRE, "agent");
            asm volatile("s_waitcnt vmcnt(0)" ::: "memory");
        }
    }
    __syncthreads();
}

struct Args { Ptrs p; int ph_lo, ph_hi; };
constexpr int LDS_BYTES = 147456;
constexpr int LDS_CTL = 131072;
__device__ __forceinline__ void moe_table(const Ptrs& P, int l, LAS unsigned char* lds) {
    LAS int* tab = (LAS int*)(lds + LDS_CTL);
    __syncthreads();
    if (threadIdx.x == 0) { const unsigned* gcnt = (const unsigned*)(P.ws + WS_CTL) + CW_GCNT + l * 16; int acc = 0;
        for (int e = 0; e < 16; ++e) { const int c = (int)__hip_atomic_load(gcnt + e, __ATOMIC_RELAXED, __HIP_MEMORY_SCOPE_AGENT); tab[e] = acc; tab[32 + e] = c; acc += (c + 255) >> 8; }
        tab[16] = acc; }
    __syncthreads();
}
template <int l>
__device__ __forceinline__ void layer_phases(const Args& a, LAS unsigned char* lds, int lo, int hi, int G, int bx, int vcu, const XcdBarrier& bar) {
#define IN(k) (lo <= (k) && (k) < hi)
#define BAR(k) do { if (lo <= (k) && (k) + 1 < hi) xcd_barrier(bar); } while (0)
    unsigned char* ws = a.p.ws;
    constexpr int pb = 2 + 8 * l;
    if (IN(pb + 0)) {
        constexpr int N = l == 0 ? P0 : P1;
        pg8::Gemm g{(const bf16_t*)(ws + WS_H), (const bf16_t*)(ws + (l == 0 ? WS_WINE : WS_WINO)), 1024, 0};
        pg8::StaticOrder S; S.init(M_, N, G, bx);
        constexpr unsigned long long modes = l == 0 ? (0x11ull | (0x22ull << 24) | (0x22ull << 48)) : ((0x33ull << 8) | (0x11ull << 16));
        pg8::EpiAct E{(bf16_t*)(ws + WS_P), N, modes, QSC};
        pg8::gemm_phase<pg8::EpiAct, pg8::StaticOrder, true, false>(lds, g, S, E);
    }
    BAR(pb + 0);
    if (IN(pb + 1)) { if constexpr (l == 0) hg::ph_hgrn<true>(a.p, lds, vcu, G); else lru::ph_lru<true>(a.p, lds, vcu, G); }
    BAR(pb + 1);
    if (IN(pb + 2)) { if constexpr (l == 0) { hg::ph_hgrn<false>(a.p, lds, vcu, G); att::ph_diffattn(a.p, lds, vcu, G); } else { lru::ph_lru<false>(a.p, lds, vcu, G); att::ph_sbattn(a.p, lds, vcu, G); } }
    BAR(pb + 2);
    if (IN(pb + 3)) {
        pg8::Gemm g{(const bf16_t*)(ws + WS_H), (const bf16_t*)(ws + (l == 0 ? WS_WOUTE : WS_WOUTO)), 1024, 0};
        pg8::StaticOrder S; S.init(M_, 1024, G, bx);
        pg8::EpiAct E{(bf16_t*)(ws + WS_P), 1024, 0ull, 1.f};
        pg8::gemm_phase<pg8::EpiAct, pg8::StaticOrder, true, false>(lds, g, S, E);
    }
    BAR(pb + 3);
    if (IN(pb + 4)) ph_lnr(a.p, l, lds);
    BAR(pb + 4);
    if (IN(pb + 5)) {
        moe_table(a.p, l, lds);
        pg8::Gemm g{(const bf16_t*)(ws + WS_H), (const bf16_t*)(ws + WS_GU) + (size_t)l * 16 * 1024 * 1024, 1024, (size_t)1024 * 1024};
        pg8::MoeOrder S{(const LAS int*)(lds + LDS_CTL), (const int*)(ws + WS_LIST), G, vcu, 4};
        pg8::EpiGU E{(bf16_t*)(ws + WS_P)};
        pg8::gemm_phase<pg8::EpiGU, pg8::MoeOrder, true, true>(lds, g, S, E);
    }
    BAR(pb + 5);
    if (IN(pb + 6)) {
        moe_table(a.p, l, lds);
        pg8::Gemm g{(const bf16_t*)(ws + WS_P), (const bf16_t*)(ws + WS_DN) + (size_t)l * 16 * 1024 * 512, 512, (size_t)1024 * 512};
        pg8::MoeOrder S{(const LAS int*)(lds + LDS_CTL), (const int*)(ws + WS_LIST), G, vcu, 4};
        pg8::EpiAct E{(bf16_t*)(ws + WS_YS), 1024, 0ull, 1.f};
        pg8::gemm_phase<pg8::EpiAct, pg8::MoeOrder, true, false>(lds, g, S, E);
    }
    BAR(pb + 6);
    if (IN(pb + 7)) { if (OPT_MOE) ph_ln2<false>(a.p, l, lds); else ph_ln2<true>(a.p, l, lds); }
    BAR(pb + 7);
#undef IN
#undef BAR
}
__global__ void __launch_bounds__(512, 2) fwd(Args a) {
    extern __shared__ __attribute__((aligned(16))) unsigned char lds_raw[];
    LAS unsigned char* lds = (LAS unsigned char*)lds_raw;
    const int lo = a.ph_lo, hi = a.ph_hi;
    const int G = gridDim.x, bx = blockIdx.x; const int vcu = (G % 8 == 0) ? (bx % 8) * (G / 8) + bx / 8 : bx;
    if (threadIdx.x < 4) ((LAS unsigned*)(lds + LDS_CTL + 256))[threadIdx.x] = 0u;
    __syncthreads();
    const XcdBarrier bar = xcd_barrier_post((unsigned*)(a.p.ws + WS_CTL) + CW_BAR, (volatile LAS unsigned*)(lds + LDS_CTL + 256));
    if (lo <= 0 && 0 < hi) ph_prologue(a.p, lds);
    if (lo <= 0 && 1 < hi) xcd_barrier(bar);
    if (lo <= 1 && 1 < hi) ph_modulate(a.p);
    if (lo <= 1 && 2 < hi) xcd_barrier(bar);
    layer_phases<0>(a, lds, lo, hi, G, bx, vcu, bar);
    layer_phases<1>(a, lds, lo, hi, G, bx, vcu, bar);
}

extern "C" void kernel_launch(void* const* d_in, const int* in_sizes, int n_in, void* d_out, int out_size, void* d_ws, size_t ws_size, hipStream_t stream) {
    static int grid = 0;
    if (grid == 0) {
        if (n_in != 26 || out_size != M_ * D_ || ws_size < WS_END) { fprintf(stderr, "kernel_launch: unexpected shapes (n_in %d out %d ws %zu)\n", n_in, out_size, ws_size); grid = -1; return; }
        int dev = 0, cus = 0;
        hipGetDevice(&dev); hipDeviceGetAttribute(&cus, hipDeviceAttributeMultiprocessorCount, dev);
        hipFuncSetAttribute((const void*)fwd, hipFuncAttributeMaxDynamicSharedMemorySize, LDS_BYTES);
        grid = cus > 0 ? cus : 256;
    }
    if (grid < 0) return;
    hipMemsetAsync((char*)d_ws + WS_CTL, 0, CTL_BYTES, stream);
    Args a{};
    for (int i = 0; i < 26; ++i) a.p.in[i] = (const float*)d_in[i];
    a.p.out = (float*)d_out; a.p.ws = (unsigned char*)d_ws;
    unsigned char* ws = (unsigned char*)d_ws;
    auto run = [&](int k) { a.ph_lo = k; a.ph_hi = k + 1; hipLaunchKernelGGL(fwd, dim3(grid), dim3(512), LDS_BYTES, stream, a); };
    bf16_t* H = (bf16_t*)(ws + WS_H); bf16_t* PR = (bf16_t*)(ws + WS_P); bf16_t* YS = (bf16_t*)(ws + WS_YS);
    if (SINGLE_LAUNCH) { a.ph_lo = 0; a.ph_hi = 18; hipLaunchKernelGGL(fwd, dim3(grid), dim3(512), LDS_BYTES, stream, a); return; }
    run(0); run(1);
    for (int l = 0; l < 2; ++l) {
        const int pb = 2 + 8 * l;
        if (l == 0) {
            const unsigned long long modes = 0x11ull | (0x22ull << 24) | (0x22ull << 48);
            if (OPT_GEMM) run(pb + 0); else hipLaunchKernelGGL(ngemm, dim3(P0 / 64, M_ / 64), dim3(256), 0, stream, H, (const bf16_t*)(ws + WS_WINE), PR, P0, 1024, modes, QSC);
            if (OPT_HG) run(pb + 1);
            if (OPT_DA) run(pb + 2); else hipLaunchKernelGGL(nda, dim3(M_ * 4 / 4), dim3(256), 0, stream, PR, H, (const float*)d_in[8], (const float*)d_in[9]);
            if (!OPT_HG) hipLaunchKernelGGL(nhg, dim3(32), dim3(512), 0, stream, PR, H, (const float*)d_in[10], (const float*)d_in[11]);
            if (OPT_GEMM) run(pb + 3); else hipLaunchKernelGGL(ngemm, dim3(1024 / 64, M_ / 64), dim3(256), 0, stream, H, (const bf16_t*)(ws + WS_WOUTE), PR, 1024, 1024, 0ull, 1.f);
        } else {
            const unsigned long long modes = (0x33ull << 8) | (0x11ull << 16);
            if (OPT_GEMM) run(pb + 0); else hipLaunchKernelGGL(ngemm, dim3(P1 / 64, M_ / 64), dim3(256), 0, stream, H, (const bf16_t*)(ws + WS_WINO), PR, P1, 1024, modes, QSC);
            if (OPT_LRU) run(pb + 1); else hipLaunchKernelGGL(nlru, dim3(64), dim3(64), 0, stream, PR, H, (const float*)d_in[14], (const float*)d_in[15], (const float*)d_in[16], (const float*)d_in[17], (const float*)d_in[18], (const float*)d_in[19], (const float*)d_in[20]);
            if (OPT_SB) run(pb + 2); else hipLaunchKernelGGL(nsb, dim3(M_ * 8 / 4), dim3(256), 0, stream, PR, H);
            if (OPT_GEMM) run(pb + 3); else hipLaunchKernelGGL(ngemm, dim3(1024 / 64, M_ / 64), dim3(256), 0, stream, H, (const bf16_t*)(ws + WS_WOUTO), PR, 1024, 1024, 0ull, 1.f);
        }
        run(pb + 4);
        if (OPT_MOE) { run(pb + 5); run(pb + 6); } else hipLaunchKernelGGL(nmoe, dim3(M_), dim3(256), 0, stream, H, (const TokInfo*)(ws + WS_TOK), (const bf16_t*)(ws + WS_GU) + (size_t)l * 16 * 1024 * 1024, (const bf16_t*)(ws + WS_DN) + (size_t)l * 16 * 1024 * 512, YS);
        run(pb + 7);
    }
}
```

```cpp
#include <hip/hip_runtime.h>
#include <cstdio>
#include <cstdint>

#define GAS __attribute__((address_space(1)))
#define LAS __attribute__((address_space(3)))
typedef unsigned short bf16_t;
typedef short bf16x8 __attribute__((ext_vector_type(8)));
typedef float f32x4 __attribute__((ext_vector_type(4)));
typedef float f32x16 __attribute__((ext_vector_type(16)));
typedef unsigned u32x4 __attribute__((ext_vector_type(4)));
typedef unsigned u32x2 __attribute__((ext_vector_type(2)));

constexpr int B_ = 8, T_ = 4096, D_ = 1024, M_ = B_ * T_;
constexpr int P0 = 3584, P1 = 2560;
constexpr int NE = 16;
constexpr float LOG2E = 1.4426950408889634f, LN2F = 0.6931471805599453f;
constexpr float ALPHA = 1.4142135623730951f;
constexpr float QSC = 0.125f * 1.4426950408889634f;
constexpr float LN_EPS = 1e-5f, RMS_EPS = 1e-6f;
constexpr float LAM_INIT0 = 0.2f;

constexpr size_t MiB = 1u << 20;
constexpr size_t WS_CTL = 0, CTL_BYTES = 1 * MiB;
constexpr size_t WS_MOD = 1 * MiB;
constexpr size_t WS_TOK = 2 * MiB;
constexpr size_t WS_LIST = 3 * MiB;
constexpr size_t WS_LRU = 5 * MiB;
constexpr size_t WS_HGD = 6 * MiB;
constexpr size_t WS_HGS = 8 * MiB;
constexpr size_t WS_WINE = 24 * MiB, WS_WOUTE = 31 * MiB, WS_WINO = 33 * MiB, WS_WOUTO = 38 * MiB;
constexpr size_t WS_GU = 40 * MiB;
constexpr size_t WS_DN = 104 * MiB;
constexpr size_t WS_H = 136 * MiB;
constexpr size_t WS_P = 200 * MiB;
constexpr size_t WS_YS = WS_P + 68 * MiB;
constexpr size_t WS_XS = 424 * MiB;
constexpr size_t WS_END = 488 * MiB;
constexpr int CW_GCNT = 64;
constexpr int CW_BAR = 4096;

#ifndef OPT_GEMM
#define OPT_GEMM 1
#endif
#ifndef OPT_SB
#define OPT_SB 1
#endif
#ifndef OPT_HG
#define OPT_HG 1
#endif
#ifndef SINGLE_LAUNCH
#define SINGLE_LAUNCH 1
#endif
#ifndef OPT_LRU
#define OPT_LRU 1
#endif
#ifndef OPT_DA
#define OPT_DA 1
#endif
#ifndef OPT_MOE
#define OPT_MOE 1
#endif
struct TokInfo { int ep1, ep2; float w1, w2; };

__device__ __forceinline__ float bf2f(bf16_t v) { return __uint_as_float((unsigned)v << 16); }
typedef float f32x2_t __attribute__((ext_vector_type(2))); typedef __bf16 bf16x2_t __attribute__((ext_vector_type(2)));
__device__ __forceinline__ unsigned cvt_pk_bf16(float lo, float hi) { f32x2_t v = {lo, hi}; bf16x2_t b = __builtin_convertvector(v, bf16x2_t); return __builtin_bit_cast(unsigned, b); }
__device__ __forceinline__ bf16_t f2bf(float f) { return (bf16_t)(cvt_pk_bf16(f, 0.f) & 0xffffu); }
__device__ __forceinline__ float fexp2(float x) { return __builtin_amdgcn_exp2f(x); }
__device__ __forceinline__ float fexp(float x) { return __builtin_amdgcn_exp2f(x * LOG2E); }
__device__ __forceinline__ float frcp(float x) { return __builtin_amdgcn_rcpf(x); }
__device__ __forceinline__ float sigmoidf_(float x) { return frcp(1.f + fexp(-x)); }
__device__ __forceinline__ float siluf_(float x) { return x * sigmoidf_(x); }
__device__ __forceinline__ float gelu_t(float x) { const float u = 0.7978845608028654f * (x + 0.044715f * x * x * x); const float t = fexp(2.f * u); return 0.5f * x * (2.f - 2.f * frcp(t + 1.f)); }
__device__ __forceinline__ float softplusf_(float x) { return fmaxf(x, 0.f) + log1pf(expf(-fabsf(x))); }
__device__ __forceinline__ float wave_sum(float v) {
#pragma unroll
    for (int o = 1; o < 64; o <<= 1) v += __shfl_xor(v, o);
    return v;
}
__device__ __forceinline__ float wave_max(float v) {
#pragma unroll
    for (int o = 1; o < 64; o <<= 1) v = fmaxf(v, __shfl_xor(v, o));
    return v;
}
__device__ __forceinline__ float act_mode(float v, int mode, float qs) {
    if (mode == 1) return v * qs;
    if (mode == 2) return siluf_(v);
    if (mode == 3) return gelu_t(v);
    return v;
}

struct Ptrs {
    const float* in[26]; float* out; unsigned char* ws;
};

__device__ __forceinline__ void transpose_item(const float* W, int K, int N, bf16_t* WT, int row_delta, LAS float* scr, int item, int lane) {
    const int nblk = N / 32, kb = item / nblk, nb = item % nblk, k0 = 64 * kb, n0 = 32 * nb;
#pragma unroll 8
    for (int i = 0; i < 32; ++i) { const int kk = 2 * i + (lane >> 5); scr[kk * 33 + (lane & 31)] = W[(size_t)(k0 + kk) * N + n0 + (lane & 31)]; }
    asm volatile("s_waitcnt lgkmcnt(0)" ::: "memory");
    const int c = lane & 7;
#pragma unroll
    for (int j = 0; j < 4; ++j) { const int n = (lane >> 3) + 8 * j; const LAS float* s = scr + (8 * c) * 33 + n;
        u32x4 o; o.x = cvt_pk_bf16(s[0 * 33], s[1 * 33]); o.y = cvt_pk_bf16(s[2 * 33], s[3 * 33]); o.z = cvt_pk_bf16(s[4 * 33], s[5 * 33]); o.w = cvt_pk_bf16(s[6 * 33], s[7 * 33]);
        *(u32x4*)(WT + (size_t)(n0 + n + row_delta) * K + k0 + 8 * c) = o; }
    asm volatile("s_waitcnt lgkmcnt(0)" ::: "memory");
}

__device__ __forceinline__ void ph_prologue(const Ptrs& P, LAS unsigned char* lds) {
    const int tid = threadIdx.x, lane = tid & 63, wid = tid >> 6, G = gridDim.x;
    unsigned char* ws = P.ws;
    {
        LAS float* cond = (LAS float*)lds;
        LAS float* part = (LAS float*)(lds + 32768);
        bool have = false;
        for (int it = blockIdx.x; it < 192; it += G) {
            if (!have) { const float* c = P.in[1]; for (int i = tid; i < 8192; i += 512) cond[i] = siluf_(c[i]); have = true; __syncthreads(); }
            const int l = it / 96, cg = it % 96, col = cg * 64 + lane;
            const float* w = P.in[2] + (size_t)l * 1024 * 6144 + col;
            float acc[8];
#pragma unroll
            for (int b = 0; b < 8; ++b) acc[b] = 0.f;
            for (int k = wid * 128; k < wid * 128 + 128; ++k) { const float wv = w[(size_t)k * 6144];
#pragma unroll
                for (int b = 0; b < 8; ++b) acc[b] += cond[b * 1024 + k] * wv; }
#pragma unroll
            for (int b = 0; b < 8; ++b) part[(wid * 8 + b) * 64 + lane] = acc[b];
            __syncthreads();
            { const int b = tid >> 6; float s = 0.f;
#pragma unroll
              for (int w8 = 0; w8 < 8; ++w8) s += part[(w8 * 8 + b) * 64 + lane];
              ((float*)(ws + WS_MOD))[(size_t)(l * 8 + b) * 6144 + col] = s + P.in[3][l * 6144 + col]; }
            __syncthreads();
        }
        __syncthreads();
    }
    LAS float* scr = (LAS float*)(lds + wid * 16384);
    const int gw = blockIdx.x * 8 + wid, NGW = G * 8;
    constexpr int I0 = 16 * 112, I1 = 512, I2 = 16 * 80, I3 = 512, IM = 256, NIT = I0 + I1 + I2 + I3 + 3 * 32 * IM;
    for (int it = gw; it < NIT; it += NGW) {
        int r = it;
        if (r < I0) { transpose_item(P.in[6], 1024, 3584, (bf16_t*)(ws + WS_WINE), 0, scr, r, lane); continue; } r -= I0;
        if (r < I1) { transpose_item(P.in[7], 1024, 1024, (bf16_t*)(ws + WS_WOUTE), 0, scr, r, lane); continue; } r -= I1;
        if (r < I2) { transpose_item(P.in[12], 1024, 2560, (bf16_t*)(ws + WS_WINO), 0, scr, r, lane); continue; } r -= I2;
        if (r < I3) { transpose_item(P.in[13], 1024, 1024, (bf16_t*)(ws + WS_WOUTO), 0, scr, r, lane); continue; } r -= I3;
        const int kind = r / (32 * IM); r -= kind * 32 * IM; const int le = r / IM, item = r % IM;
        if (kind < 2) {
            const int nb = item % 16, n0 = nb * 32; const int delta = (256 * (n0 >> 7) + 128 * kind + (n0 & 127)) - n0;
            transpose_item((kind == 0 ? P.in[23] : P.in[24]) + (size_t)le * 1024 * 512, 1024, 512, (bf16_t*)(ws + WS_GU) + (size_t)le * 1024 * 1024, delta, scr, item, lane);
        } else {
            transpose_item(P.in[25] + (size_t)le * 512 * 1024, 512, 1024, (bf16_t*)(ws + WS_DN) + (size_t)le * 1024 * 512, 0, scr, item, lane);
        }
    }
}

__device__ __forceinline__ void ph_modulate(const Ptrs& P) {
    const int tid = threadIdx.x, lane = tid & 63, wid = tid >> 6;
    const int gw = blockIdx.x * 8 + wid, NGW = gridDim.x * 8;
    const float* mod = (const float*)(P.ws + WS_MOD);
    bf16_t* H = (bf16_t*)(P.ws + WS_H);
    for (int m = gw; m < M_; m += NGW) {
        const int b = m >> 12; const float* mb = mod + (size_t)b * 6144;
        const float* xr = P.in[0] + (size_t)m * D_;
#pragma unroll
        for (int j = 0; j < 4; ++j) { const int c = 4 * lane + 256 * j;
            const f32x4 x = *(const f32x4*)(xr + c), sh = *(const f32x4*)(mb + c), sc = *(const f32x4*)(mb + 1024 + c);
            const f32x4 h = x * (1.f + sc) + sh; u32x2 o; o.x = cvt_pk_bf16(h[0], h[1]); o.y = cvt_pk_bf16(h[2], h[3]);
            *(u32x2*)(H + (size_t)m * D_ + c) = o; }
    }
}

__device__ __forceinline__ f32x4 bf4(u32x2 v) { f32x4 y; y[0] = __uint_as_float(v.x << 16); y[1] = __uint_as_float(v.x & 0xffff0000u); y[2] = __uint_as_float(v.y << 16); y[3] = __uint_as_float(v.y & 0xffff0000u); return y; }
__device__ __forceinline__ float swapother(float v, int hi) { auto rr = __builtin_amdgcn_permlane32_swap(__float_as_uint(v), __float_as_uint(v), false, false); return hi ? __uint_as_float(rr[0]) : __uint_as_float(rr[1]); }
__device__ __forceinline__ float rdlane(float v, int l) { return __int_as_float(__builtin_amdgcn_readlane(__float_as_int(v), l)); }
__device__ __forceinline__ void ph_lnr(const Ptrs& P, int l, LAS unsigned char* lds) {
    const int tid = threadIdx.x, lane = tid & 63, wid = tid >> 6, G = gridDim.x;
    unsigned char* ws = P.ws;
    LAS f32x4* RW = (LAS f32x4*)lds;
    LAS int* se = (LAS int*)(lds + 65536);
    LAS int* hist = (LAS int*)(lds + 65536 + 1024);
    LAS int* base = (LAS int*)(lds + 65536 + 1024 + 64);
    const float* rw = P.in[21];
    for (int i = tid; i < 4096; i += 512) { const int idx = i >> 6, ln = i & 63, q = idx & 3, ji = idx >> 2, j = ji >> 2, ii = ji & 3; const int c = 4 * ln + 256 * j + ii;
        RW[i] = *(const f32x4*)(rw + (size_t)c * 16 + 4 * q); }
    if (tid < 16) hist[tid] = 0;
    __syncthreads();
    const float* mod = (const float*)(ws + WS_MOD) + (size_t)l * 8 * 6144;
    const float* xsrc = P.in[0]; bf16_t* XS = (bf16_t*)(ws + WS_XS);
    const bf16_t* Y = (const bf16_t*)(ws + WS_P);
    bf16_t* H = (bf16_t*)(ws + WS_H);
    TokInfo* tok = (TokInfo*)(ws + WS_TOK);
    int* list = (int*)(ws + WS_LIST);
    unsigned* gcnt = (unsigned*)(ws + WS_CTL) + CW_GCNT + l * 16;
    const float* lng = P.in[4] + (size_t)(l * 2 + 0) * 1024, * lnb = P.in[5] + (size_t)(l * 2 + 0) * 1024;
    float rb[16];
#pragma unroll
    for (int e = 0; e < 16; ++e) rb[e] = P.in[22][e];
    const int hi = lane >> 5;
    for (int ch = blockIdx.x; ch < M_ / 128; ch += G) {
        const int b = (ch * 128) >> 12; const float* mb = mod + (size_t)b * 6144;
        f32x4 vg1[4], vg[4], vb[4], vsh[4], vsc[4];
#pragma unroll
        for (int j = 0; j < 4; ++j) { const int c = 4 * lane + 256 * j; vg1[j] = 1.f + *(const f32x4*)(mb + 2048 + c); vg[j] = *(const f32x4*)(lng + c); vb[j] = *(const f32x4*)(lnb + c);
            vsh[j] = *(const f32x4*)(mb + 3072 + c); vsc[j] = 1.f + *(const f32x4*)(mb + 4096 + c); }
        const int m0 = ch * 128 + wid * 16;
        f32x4 xn[4]; u32x2 yn[4];
#pragma unroll
        for (int j = 0; j < 4; ++j) { const int c = 4 * lane + 256 * j; xn[j] = (l == 0) ? *(const f32x4*)(xsrc + (size_t)m0 * D_ + c) : bf4(*(const u32x2*)(XS + (size_t)m0 * D_ + c)); yn[j] = *(const u32x2*)(Y + (size_t)m0 * D_ + c); }
        for (int i = 0; i < 16; ++i) {
            const int rl = wid * 16 + i, m = m0 + i;
            f32x4 v[4]; float s = 0.f;
#pragma unroll
            for (int j = 0; j < 4; ++j) { v[j] = ALPHA * xn[j] + vg1[j] * bf4(yn[j]); s += (v[j][0] + v[j][1]) + (v[j][2] + v[j][3]); }
            if (i < 15) {
#pragma unroll
                for (int j = 0; j < 4; ++j) { const int c = 4 * lane + 256 * j; xn[j] = (l == 0) ? *(const f32x4*)(xsrc + (size_t)(m + 1) * D_ + c) : bf4(*(const u32x2*)(XS + (size_t)(m + 1) * D_ + c)); yn[j] = *(const u32x2*)(Y + (size_t)(m + 1) * D_ + c); } }
            const float mean = wave_sum(s) * (1.f / D_); float s2 = 0.f;
#pragma unroll
            for (int j = 0; j < 4; ++j) { v[j] = v[j] - mean; s2 += (v[j][0] * v[j][0] + v[j][1] * v[j][1]) + (v[j][2] * v[j][2] + v[j][3] * v[j][3]); }
            const float rstd = 1.f / sqrtf(wave_sum(s2) * (1.f / D_) + LN_EPS);
            float acc[16];
#pragma unroll
            for (int e = 0; e < 16; ++e) acc[e] = 0.f;
#pragma unroll
            for (int j = 0; j < 4; ++j) { const int c = 4 * lane + 256 * j;
                const f32x4 x1 = v[j] * rstd * vg[j] + vb[j];
                { u32x2 ox; ox.x = cvt_pk_bf16(x1[0], x1[1]); ox.y = cvt_pk_bf16(x1[2], x1[3]); *(u32x2*)(XS + (size_t)m * D_ + c) = ox; }
                const f32x4 h = x1 * vsc[j] + vsh[j]; u32x2 o; o.x = cvt_pk_bf16(h[0], h[1]); o.y = cvt_pk_bf16(h[2], h[3]);
                *(u32x2*)(H + (size_t)m * D_ + c) = o;
#pragma unroll
                for (int ii = 0; ii < 4; ++ii)
#pragma unroll
                    for (int q = 0; q < 4; ++q) { const f32x4 w = RW[((j * 4 + ii) * 4 + q) * 64 + lane];
                        acc[4 * q + 0] += h[ii] * w[0]; acc[4 * q + 1] += h[ii] * w[1]; acc[4 * q + 2] += h[ii] * w[2]; acc[4 * q + 3] += h[ii] * w[3]; }
                asm volatile("" ::: "memory");
            }
            float r8[8], r4[4], r2[2], r1;
#pragma unroll
            for (int k = 0; k < 8; ++k) { const float send = hi ? acc[k] : acc[8 + k]; const float keep = hi ? acc[8 + k] : acc[k]; r8[k] = keep + swapother(send, hi); }
            { const int b4 = (lane >> 4) & 1;
#pragma unroll
              for (int k = 0; k < 4; ++k) { const float send = b4 ? r8[k] : r8[4 + k]; const float keep = b4 ? r8[4 + k] : r8[k]; r4[k] = keep + __shfl_xor(send, 16); } }
            { const int b3 = (lane >> 3) & 1;
#pragma unroll
              for (int k = 0; k < 2; ++k) { const float send = b3 ? r4[k] : r4[2 + k]; const float keep = b3 ? r4[2 + k] : r4[k]; r2[k] = keep + __shfl_xor(send, 8); } }
            { const int b2 = (lane >> 2) & 1; const float send = b2 ? r2[0] : r2[1]; const float keep = b2 ? r2[1] : r2[0]; r1 = keep + __shfl_xor(send, 4); }
            r1 += __shfl_xor(r1, 2); r1 += __shfl_xor(r1, 1);
            float p[16]; float mx = -1e30f;
#pragma unroll
            for (int e = 0; e < 16; ++e) { p[e] = rdlane(r1, 4 * e) + rb[e]; mx = fmaxf(mx, p[e]); }
            float ps = 0.f;
#pragma unroll
            for (int e = 0; e < 16; ++e) { p[e] = expf(p[e] - mx); ps += p[e]; }
            const float inv = 1.f / ps;
#pragma unroll
            for (int e = 0; e < 16; ++e) p[e] *= inv;
            int gs = 0; float best = -1.f, q0 = 0.f, q1 = 0.f, q2 = 0.f, q3 = 0.f;
#pragma unroll
            for (int g = 0; g < 4; ++g) { const float a = p[4 * g], b2 = p[4 * g + 1], c2 = p[4 * g + 2], d2 = p[4 * g + 3];
                const float t2 = fmaxf(fmaxf(fmaxf(a + b2, a + c2), fmaxf(a + d2, b2 + c2)), fmaxf(b2 + d2, c2 + d2));
                const bool better = t2 > best;
                best = better ? t2 : best; gs = better ? g : gs; q0 = better ? a : q0; q1 = better ? b2 : q1; q2 = better ? c2 : q2; q3 = better ? d2 : q3; }
            int i1 = 0; float t1 = q0;
            if (q1 > t1) { t1 = q1; i1 = 1; } if (q2 > t1) { t1 = q2; i1 = 2; } if (q3 > t1) { t1 = q3; i1 = 3; }
            int i2 = -1; float t2v = -1.f;
            if (i1 != 0 && q0 > t2v) { t2v = q0; i2 = 0; } if (i1 != 1 && q1 > t2v) { t2v = q1; i2 = 1; }
            if (i1 != 2 && q2 > t2v) { t2v = q2; i2 = 2; } if (i1 != 3 && q3 > t2v) { t2v = q3; i2 = 3; }
            const float wsum = t1 + t2v;
            if (lane == 0) { se[rl * 2 + 0] = gs * 4 + i1; se[rl * 2 + 1] = gs * 4 + i2; tok[m].w1 = t1 / wsum; tok[m].w2 = t2v / wsum; }
        }
        __syncthreads();
        int e = 0, rank = 0;
        if (tid < 256) { e = se[tid]; rank = atomicAdd((int*)&hist[e], 1); }
        __syncthreads();
        if (tid < 16) { base[tid] = (int)__hip_atomic_fetch_add(gcnt + tid, (unsigned)hist[tid], __ATOMIC_RELAXED, __HIP_MEMORY_SCOPE_AGENT); }
        __syncthreads();
        if (tid < 256) { const int pos = base[e] + rank, m = ch * 128 + (tid >> 1); list[(size_t)e * M_ + pos] = m;
            if (tid & 1) tok[m].ep2 = (e << 20) | pos; else tok[m].ep1 = (e << 20) | pos; }
        if (tid < 16) hist[tid] = 0;
        __syncthreads();
    }
}

template <bool NAIVE_Y>
__device__ __forceinline__ void ph_ln2(const Ptrs& P, int l, LAS unsigned char* lds) {
    const int tid = threadIdx.x, lane = tid & 63, wid = tid >> 6;
    unsigned char* ws = P.ws;
    LAS int* segrow = (LAS int*)lds;
    if (tid == 0) { const unsigned* gcnt = (const unsigned*)(ws + WS_CTL) + CW_GCNT + l * 16; int acc = 0;
        for (int e = 0; e < 16; ++e) { segrow[e] = acc; const unsigned c = __hip_atomic_load(gcnt + e, __ATOMIC_RELAXED, __HIP_MEMORY_SCOPE_AGENT); acc += (int)((c + 255u) >> 8) * 256; } }
    __syncthreads();
    const float* mod = (const float*)(ws + WS_MOD);
    const bf16_t* YS = (const bf16_t*)(ws + WS_YS);
    const TokInfo* tok = (const TokInfo*)(ws + WS_TOK);
    bf16_t* H = (bf16_t*)(ws + WS_H); bf16_t* XS = (bf16_t*)(ws + WS_XS);
    const float* lng = P.in[4] + (size_t)(l * 2 + 1) * 1024, * lnb = P.in[5] + (size_t)(l * 2 + 1) * 1024;
    const int gw = blockIdx.x * 8 + wid, NGW = gridDim.x * 8;
    for (int cc = gw; cc < M_ / 16; cc += NGW) {
        const int m0 = cc * 16, b = m0 >> 12; const float* mb = mod + (size_t)(l * 8 + b) * 6144; const float* mb1 = mod + (size_t)(8 + b) * 6144;
        f32x4 vg2[4], vg[4], vb[4], vsh[4], vsc[4];
#pragma unroll
        for (int j = 0; j < 4; ++j) { const int c = 4 * lane + 256 * j; vg2[j] = 1.f + *(const f32x4*)(mb + 5120 + c); vg[j] = *(const f32x4*)(lng + c); vb[j] = *(const f32x4*)(lnb + c);
            if (l == 0) { vsh[j] = *(const f32x4*)(mb1 + c); vsc[j] = 1.f + *(const f32x4*)(mb1 + 1024 + c); } }
        int r1l = 0, r2l = 0; float w1l = 0.f, w2l = 0.f;
        if (lane < 16) { const TokInfo ti = tok[m0 + lane]; r1l = NAIVE_Y ? (m0 + lane) : (segrow[ti.ep1 >> 20] + (ti.ep1 & 0xfffff)); r2l = NAIVE_Y ? (m0 + lane) : (segrow[ti.ep2 >> 20] + (ti.ep2 & 0xfffff)); w1l = ti.w1; w2l = ti.w2; }
        f32x4 xn[4]; u32x2 yan[4], ybn[4];
        { const size_t r1 = (size_t)__builtin_amdgcn_readlane(r1l, 0), r2 = (size_t)__builtin_amdgcn_readlane(r2l, 0);
#pragma unroll
          for (int j = 0; j < 4; ++j) { const int c = 4 * lane + 256 * j; xn[j] = bf4(*(const u32x2*)(XS + (size_t)m0 * D_ + c)); yan[j] = *(const u32x2*)(YS + r1 * D_ + c); ybn[j] = *(const u32x2*)(YS + r2 * D_ + c); } }
#pragma unroll 1
        for (int i = 0; i < 16; ++i) {
            const int m = m0 + i; const float w1 = rdlane(w1l, i), w2 = rdlane(w2l, i);
            f32x4 v[4]; float s = 0.f;
#pragma unroll
            for (int j = 0; j < 4; ++j) { f32x4 y = bf4(yan[j]); if (!NAIVE_Y) y = w1 * y + w2 * bf4(ybn[j]); v[j] = ALPHA * xn[j] + vg2[j] * y; s += (v[j][0] + v[j][1]) + (v[j][2] + v[j][3]); }
            if (i < 15) { const size_t r1 = (size_t)__builtin_amdgcn_readlane(r1l, i + 1), r2 = (size_t)__builtin_amdgcn_readlane(r2l, i + 1);
#pragma unroll
                for (int j = 0; j < 4; ++j) { const int c = 4 * lane + 256 * j; xn[j] = bf4(*(const u32x2*)(XS + (size_t)(m + 1) * D_ + c)); yan[j] = *(const u32x2*)(YS + r1 * D_ + c); ybn[j] = *(const u32x2*)(YS + r2 * D_ + c); } }
            const float mean = wave_sum(s) * (1.f / D_); float s2 = 0.f;
#pragma unroll
            for (int j = 0; j < 4; ++j) { v[j] = v[j] - mean; s2 += (v[j][0] * v[j][0] + v[j][1] * v[j][1]) + (v[j][2] * v[j][2] + v[j][3] * v[j][3]); }
            const float rstd = 1.f / sqrtf(wave_sum(s2) * (1.f / D_) + LN_EPS);
#pragma unroll
            for (int j = 0; j < 4; ++j) { const int c = 4 * lane + 256 * j;
                const f32x4 x2 = v[j] * rstd * vg[j] + vb[j];
                if (l == 1) *(f32x4*)(P.out + (size_t)m * D_ + c) = x2; else { u32x2 ox; ox.x = cvt_pk_bf16(x2[0], x2[1]); ox.y = cvt_pk_bf16(x2[2], x2[3]); *(u32x2*)(XS + (size_t)m * D_ + c) = ox; }
                if (l == 0) { const f32x4 h = x2 * vsc[j] + vsh[j]; u32x2 o; o.x = cvt_pk_bf16(h[0], h[1]); o.y = cvt_pk_bf16(h[2], h[3]); *(u32x2*)(H + (size_t)m * D_ + c) = o; }
            }
        }
    }
}

__global__ void __launch_bounds__(256) ngemm(const bf16_t* A, const bf16_t* Bt, bf16_t* C, int N, int K, unsigned long long modes, float qs) {
    __shared__ float As[32][65], Bs[32][65];
    const int tid = threadIdx.x, tx = tid & 15, ty = tid >> 4;
    const int m0 = blockIdx.y * 64, n0 = blockIdx.x * 64;
    float acc[4][4] = {};
    const int lr = tid >> 2, lk = (tid & 3) * 8;
    for (int k0 = 0; k0 < K; k0 += 32) {
        const bf16x8 av = *(const bf16x8*)(A + (size_t)(m0 + lr) * K + k0 + lk), bv = *(const bf16x8*)(Bt + (size_t)(n0 + lr) * K + k0 + lk);
#pragma unroll
        for (int i = 0; i < 8; ++i) { As[lk + i][lr] = bf2f((bf16_t)av[i]); Bs[lk + i][lr] = bf2f((bf16_t)bv[i]); }
        __syncthreads();
#pragma unroll 8
        for (int kk = 0; kk < 32; ++kk) { float a[4], b[4];
#pragma unroll
            for (int i = 0; i < 4; ++i) { a[i] = As[kk][ty * 4 + i]; b[i] = Bs[kk][tx * 4 + i]; }
#pragma unroll
            for (int i = 0; i < 4; ++i)
#pragma unroll
                for (int j = 0; j < 4; ++j) acc[i][j] += a[i] * b[j]; }
        __syncthreads();
    }
    const int mode = (int)((modes >> (4 * (n0 >> 8))) & 15ull);
#pragma unroll
    for (int i = 0; i < 4; ++i)
#pragma unroll
        for (int j = 0; j < 4; ++j) C[(size_t)(m0 + ty * 4 + i) * N + n0 + tx * 4 + j] = f2bf(act_mode(acc[i][j], mode, qs));
}

__global__ void __launch_bounds__(256) nda(const bf16_t* proj, bf16_t* mix, const float* dlam, const float* gain) {
    const int lane = threadIdx.x & 63, rid = blockIdx.x * 4 + (threadIdx.x >> 6);
    const int h = rid & 3, tokn = rid >> 2, b = tokn >> 12, i = tokn & 4095;
    float d01 = 0.f, d23 = 0.f;
    { const float a = dlam[lane] * dlam[64 + lane], c = dlam[128 + lane] * dlam[192 + lane]; d01 = wave_sum(a); d23 = wave_sum(c); }
    const float lam = expf(d01) - expf(d23) + LAM_INIT0;
    const float slope2 = exp2f(-2.f * (float)(h + 1)) * LOG2E;
    const bf16_t* qrow = proj + (size_t)tokn * P0 + h * 128;
    const size_t rb = (size_t)b * T_;
    float m0 = -1e30f, l0 = 0.f, m1 = -1e30f, l1 = 0.f;
    const int nch = (i >> 6) + 1;
    for (int jb = 0; jb < nch; ++jb) {
        const int j = jb * 64 + lane; const bool valid = j <= i;
        const bf16_t* krow = proj + (rb + (valid ? j : i)) * P0 + 512 + h * 128;
        float s0 = 0.f, s1 = 0.f;
        for (int d = 0; d < 64; ++d) { s0 += bf2f(qrow[d]) * bf2f(krow[d]); s1 += bf2f(qrow[64 + d]) * bf2f(krow[64 + d]); }
        const float bias = -slope2 * (float)(i - j); s0 += bias; s1 += bias;
        if (valid) { float mn = fmaxf(m0, s0); l0 = l0 * fexp2(m0 - mn) + fexp2(s0 - mn); m0 = mn; mn = fmaxf(m1, s1); l1 = l1 * fexp2(m1 - mn) + fexp2(s1 - mn); m1 = mn; }
    }
    const float M0 = wave_max(m0), M1 = wave_max(m1);
    const float L0 = wave_sum(l0 * fexp2(m0 - M0)), L1 = wave_sum(l1 * fexp2(m1 - M1));
    const float i0 = 1.f / L0, i1 = lam / L1;
    float o0 = 0.f, o1 = 0.f;
    for (int jb = 0; jb < nch; ++jb) {
        const int j = jb * 64 + lane; const bool valid = j <= i;
        const bf16_t* krow = proj + (rb + (valid ? j : i)) * P0 + 512 + h * 128;
        float s0 = 0.f, s1 = 0.f;
        for (int d = 0; d < 64; ++d) { s0 += bf2f(qrow[d]) * bf2f(krow[d]); s1 += bf2f(qrow[64 + d]) * bf2f(krow[64 + d]); }
        const float bias = -slope2 * (float)(i - j); s0 += bias; s1 += bias;
        const float a = valid ? (fexp2(s0 - M0) * i0 - fexp2(s1 - M1) * i1) : 0.f;
        const int jmax = min(64, i + 1 - jb * 64);
        for (int jj = 0; jj < jmax; ++jj) { const float aj = __shfl(a, jj); const bf16_t* vrow = proj + (rb + jb * 64 + jj) * P0 + 1024 + h * 128;
            o0 += aj * bf2f(vrow[lane]); o1 += aj * bf2f(vrow[64 + lane]); }
    }
    const float ssq = wave_sum(o0 * o0 + o1 * o1);
    const float rstd = 1.f / sqrtf(ssq * (1.f / 128.f) + RMS_EPS);
    bf16_t* orow = mix + (size_t)tokn * D_ + h * 128;
    orow[lane] = f2bf(o0 * rstd * gain[lane] * (1.f - LAM_INIT0)); orow[64 + lane] = f2bf(o1 * rstd * gain[64 + lane] * (1.f - LAM_INIT0));
}

__global__ void __launch_bounds__(512) nhg(const bf16_t* proj, bf16_t* mix, const float* gamma, const float* hgain) {
    __shared__ float qs[128], fs[128], ks[128], part[4][128], red[2];
    const int tid = threadIdx.x, dv = tid & 127, dq = tid >> 7, b = blockIdx.x >> 2, h = blockIdx.x & 3;
    float lb = 0.f;
    if (tid < 128) { const int c = h * 128 + tid; const float g0 = gamma[c], g1 = gamma[512 + c], g2 = gamma[1024 + c]; const float mx = fmaxf(g0, fmaxf(g1, g2));
        const float e0 = expf(g0 - mx), e1 = expf(g1 - mx), e2 = expf(g2 - mx); lb = e0 / (e0 + e1 + e2); }
    float S[32];
#pragma unroll
    for (int r = 0; r < 32; ++r) S[r] = 0.f;
    const float gn = hgain[dv];
    for (int t = 0; t < T_; ++t) {
        const bf16_t* row = proj + ((size_t)b * T_ + t) * P0;
        if (tid < 128) { const float q = bf2f(row[1536 + h * 128 + tid]), fl = bf2f(row[2048 + h * 128 + tid]);
            const float f = lb + (1.f - lb) * sigmoidf_(fl); qs[tid] = q; fs[tid] = f; ks[tid] = 1.f - f; }
        const float v = bf2f(row[2560 + h * 128 + dv]);
        __syncthreads();
        float p = 0.f;
#pragma unroll
        for (int r = 0; r < 32; ++r) { const int dk = dq * 32 + r; S[r] = fs[dk] * S[r] + ks[dk] * v; p += qs[dk] * S[r]; }
        part[dq][dv] = p;
        __syncthreads();
        float o = 0.f;
        if (tid < 128) { o = part[0][dv] + part[1][dv] + part[2][dv] + part[3][dv]; const float ss = wave_sum(o * o); if ((tid & 63) == 0) red[tid >> 6] = ss; }
        __syncthreads();
        if (tid < 128) { const float rstd = 1.f / sqrtf((red[0] + red[1]) * (1.f / 128.f) + RMS_EPS);
            mix[((size_t)b * T_ + t) * D_ + 512 + h * 128 + dv] = f2bf(o * rstd * gn * bf2f(row[3072 + h * 128 + dv])); }
    }
}

__global__ void __launch_bounds__(64) nlru(const bf16_t* proj, bf16_t* mix, const float* convw, const float* convb, const float* wa, const float* ba, const float* wx, const float* bx, const float* lam) {
    __shared__ float WA[64][64], WX[64][64], xcs[64];
    const int lane = threadIdx.x, b = blockIdx.x >> 3, g = blockIdx.x & 7, c = g * 64 + lane;
    for (int i = 0; i < 64; ++i) { WA[i][lane] = wa[(size_t)(g * 64 + i) * 64 + lane]; WX[i][lane] = wx[(size_t)(g * 64 + i) * 64 + lane]; }
    const float w0 = convw[c], w1 = convw[512 + c], w2 = convw[1024 + c], w3 = convw[1536 + c], cb = convb[c];
    const float bav = ba[c], bxv = bx[c], sp = softplusf_(-lam[c]);
    float x3 = 0.f, x2 = 0.f, x1 = 0.f, hst = 0.f;
    __syncthreads();
    for (int t = 0; t < T_; ++t) {
        const bf16_t* row = proj + ((size_t)b * T_ + t) * P1;
        const float xr = bf2f(row[c]);
        const float xc = w0 * x3 + w1 * x2 + w2 * x1 + w3 * xr + cb; x3 = x2; x2 = x1; x1 = xr;
        xcs[lane] = xc;
        __syncthreads();
        float ga = bav, gx = bxv;
#pragma unroll 16
        for (int i = 0; i < 64; ++i) { const float xv = xcs[i]; ga += xv * WA[i][lane]; gx += xv * WX[i][lane]; }
        __syncthreads();
        const float r = sigmoidf_(ga), ii = sigmoidf_(gx);
        const float la = -8.f * r * sp, a = expf(la);
        const float u = sqrtf(fmaxf(-expm1f(2.f * la), 1e-12f)) * (ii * xc);
        hst = a * hst + u;
        mix[((size_t)b * T_ + t) * D_ + c] = f2bf(bf2f(row[512 + c]) * hst);
    }
}

__global__ void __launch_bounds__(256) nsb(const bf16_t* proj, bf16_t* mix) {
    const int lane = threadIdx.x & 63, rid = blockIdx.x * 4 + (threadIdx.x >> 6);
    const int h = rid & 7, tokn = rid >> 3, b = tokn >> 12, i = tokn & 4095;
    const bf16_t* qrow = proj + (size_t)tokn * P1 + 1024 + h * 64;
    const size_t rb = (size_t)b * T_;
    float o = 0.f, carry = 0.f;
    for (int jb = (i - 1) >> 6; jb >= 0 && i > 0; --jb) {
        const int j = jb * 64 + lane; const bool valid = j < i;
        const bf16_t* krow = proj + (rb + (valid ? j : 0)) * P1 + 1536 + h * 64;
        float z = 0.f;
        for (int d = 0; d < 64; ++d) z += bf2f(qrow[d]) * bf2f(krow[d]);
        z *= LN2F;
        const float spz = softplusf_(z);
        const float l1m = valid ? -spz : 0.f;
        float inc = l1m;
#pragma unroll
        for (int off = 1; off < 64; off <<= 1) { const float t = __shfl_down(inc, off); if (lane + off < 64) inc += t; }
        const float after = carry + (inc - l1m);
        const float a = valid ? expf((z - spz) + after) : 0.f;
        carry += __shfl(inc, 0);
        const int jmax = min(64, i - jb * 64);
        for (int jj = 0; jj < jmax; ++jj) { const float aj = __shfl(a, jj); o += aj * bf2f(proj[(rb + jb * 64 + jj) * P1 + 2048 + h * 64 + lane]); }
    }
    mix[(size_t)tokn * D_ + 512 + h * 64 + lane] = f2bf(o);
}

__global__ void __launch_bounds__(256) nmoe(const bf16_t* H, const TokInfo* tok, const bf16_t* GU, const bf16_t* DN, bf16_t* ymoe) {
    __shared__ float hs[1024], he[512];
    const int tid = threadIdx.x, m = blockIdx.x;
    for (int i = tid; i < 1024; i += 256) hs[i] = bf2f(H[(size_t)m * D_ + i]);
    const TokInfo ti = tok[m];
    float y[4] = {0.f, 0.f, 0.f, 0.f};
    __syncthreads();
    for (int k = 0; k < 2; ++k) {
        const int e = (k == 0 ? ti.ep1 : ti.ep2) >> 20; const float w = k == 0 ? ti.w1 : ti.w2;
        for (int jj = 0; jj < 2; ++jj) { const int j = tid + 256 * jj; const int rg = 256 * (j >> 7) + (j & 127);
            const bf16_t* gr = GU + ((size_t)e * 1024 + rg) * 1024, * ur = gr + 128 * 1024;
            float g = 0.f, u = 0.f;
            for (int kk = 0; kk < 1024; kk += 8) { const bf16x8 gv = *(const bf16x8*)(gr + kk), uv = *(const bf16x8*)(ur + kk);
#pragma unroll
                for (int i = 0; i < 8; ++i) { g += hs[kk + i] * bf2f((bf16_t)gv[i]); u += hs[kk + i] * bf2f((bf16_t)uv[i]); } }
            he[j] = bf2f(f2bf(siluf_(g) * u)); }
        __syncthreads();
        for (int nn = 0; nn < 4; ++nn) { const int n = tid + 256 * nn; const bf16_t* dr = DN + ((size_t)e * 1024 + n) * 512; float s = 0.f;
            for (int kk = 0; kk < 512; kk += 8) { const bf16x8 dv = *(const bf16x8*)(dr + kk);
#pragma unroll
                for (int i = 0; i < 8; ++i) s += he[kk + i] * bf2f((bf16_t)dv[i]); }
            y[nn] += w * s; }
        __syncthreads();
    }
    for (int nn = 0; nn < 4; ++nn) ymoe[(size_t)m * D_ + tid + 256 * nn] = f2bf(y[nn]);
}

namespace pg8 {
constexpr int BM = 256, BK = 64, HALF = 128, HTB = HALF * BK * 2, STAGE_BYTES = 8 * HTB, NXCD = 8, WGM = 8;
__host__ __device__ __forceinline__ int lds_byte(int r, int c) { const int st = (r >> 4) * 2 + (c >> 5), rr = r & 15, cc = c & 31, ob = rr * 64 + cc * 2; return st * 1024 + (ob ^ (((ob >> 9) & 1) << 5)); }
__host__ __device__ __forceinline__ void stage_rc(int b, int& R, int& C) { const int st = b / 1024, sb = b % 1024, swz = sb ^ (((sb >> 9) & 1) << 5); R = (st >> 1) * 16 + swz / 64; C = (st & 1) * 32 + (swz % 64) / 2; }
__host__ __device__ __forceinline__ int perm32(int rho) { const int n = rho >> 4, i = rho & 15; return 8 * (i >> 2) + 4 * n + (i & 3); }
struct Unit { int pm, pn, e, nvalid; const int* rowmap; };
struct Gemm { const bf16_t* A; const bf16_t* Bt; int K; size_t bstride; };

struct StaticOrder {
    int nM, nN, nwg, G, c;
    __device__ void init(int M, int N, int G_, int c_) { nM = M / BM; nN = N / BM; nwg = nM * nN; G = G_; c = c_; }
    __device__ bool next(int i, Unit& u) const {
        const long L = (long)i * G + c; if (L >= nwg) return false;
        int wgid = (int)L; { const int q = nwg / NXCD, r = nwg % NXCD, xcd = wgid % NXCD, off = wgid / NXCD; wgid = (xcd < r ? xcd * (q + 1) : r * (q + 1) + (xcd - r) * q) + off; }
        const int nig = WGM * nN, gid = wgid / nig, fm = gid * WGM, gsz = (nM - fm) < WGM ? (nM - fm) : WGM;
        u.pm = fm + ((wgid % nig) % gsz); u.pn = (wgid % nig) / gsz; u.e = 0; u.nvalid = 256; u.rowmap = nullptr; return true;
    }
};
struct MoeOrder {
    const LAS int* tab; const int* list; int G, c, npn;
    __device__ bool next(int i, Unit& u) const {
        const int L = i * G + c; const int total = tab[16] * npn; if (L >= total) return false;
        const int tile = L / npn; u.pn = L - tile * npn; int e = 0;
#pragma unroll
        for (int j = 1; j < 16; ++j) e += (tile >= tab[j]) ? 1 : 0;
        const int mt = tile - tab[e]; u.pm = tile; u.e = e; const int rem = tab[32 + e] - mt * 256; u.nvalid = rem < 256 ? rem : 256;
        u.rowmap = list + (size_t)e * M_ + mt * 256; return true;
    }
};

template <int MODE> __device__ __forceinline__ f32x4 act4(f32x4 v, float qs) {
    if (MODE == 1) return v * qs;
    if (MODE == 2) { f32x4 o; o[0] = siluf_(v[0]); o[1] = siluf_(v[1]); o[2] = siluf_(v[2]); o[3] = siluf_(v[3]); return o; }
    if (MODE == 3) { f32x4 o; o[0] = gelu_t(v[0]); o[1] = gelu_t(v[1]); o[2] = gelu_t(v[2]); o[3] = gelu_t(v[3]); return o; }
    return v;
}
struct EpiAct {
    static constexpr bool PERM = true;
    bf16_t* O; int ldc; unsigned long long modes; float qs;
    template <int MODE> __device__ __forceinline__ void store(const f32x4 (&acc)[2][2][4][2], const Unit& u, int wr, int wc, int fr, int fq) const {
        const int row0 = u.pm * BM + wr * 64 + fr, col0 = u.pn * BM + wc * 32 + 8 * fq;
#pragma unroll
        for (int ai = 0; ai < 2; ++ai)
#pragma unroll
            for (int m = 0; m < 4; ++m) { bf16_t* rowp = O + (size_t)(row0 + ai * HALF + m * 16) * ldc + col0;
#pragma unroll
                for (int bj = 0; bj < 2; ++bj) { const f32x4 v0 = act4<MODE>(acc[ai][bj][m][0], qs), v1 = act4<MODE>(acc[ai][bj][m][1], qs);
                    u32x4 w; w.x = cvt_pk_bf16(v0[0], v0[1]); w.y = cvt_pk_bf16(v0[2], v0[3]); w.z = cvt_pk_bf16(v1[0], v1[1]); w.w = cvt_pk_bf16(v1[2], v1[3]);
                    *(u32x4*)(rowp + bj * HALF) = w; } }
    }
    __device__ __forceinline__ void operator()(const f32x4 (&acc)[2][2][4][2], const Unit& u, int wr, int wc, int fr, int fq) const {
        const int mode = (int)((modes >> (4 * u.pn)) & 15ull);
        if (mode == 0) store<0>(acc, u, wr, wc, fr, fq); else if (mode == 1) store<1>(acc, u, wr, wc, fr, fq); else if (mode == 2) store<2>(acc, u, wr, wc, fr, fq); else store<3>(acc, u, wr, wc, fr, fq);
    }
};
struct EpiGU {
    static constexpr bool PERM = true;
    bf16_t* O;
    __device__ __forceinline__ void operator()(const f32x4 (&acc)[2][2][4][2], const Unit& u, int wr, int wc, int fr, int fq) const {
        const int row0 = u.pm * BM + wr * 64 + fr, col0 = u.pn * HALF + wc * 32 + 8 * fq;
#pragma unroll
        for (int ai = 0; ai < 2; ++ai)
#pragma unroll
            for (int m = 0; m < 4; ++m) { f32x4 v0 = act4<2>(acc[ai][0][m][0], 1.f) * acc[ai][1][m][0], v1 = act4<2>(acc[ai][0][m][1], 1.f) * acc[ai][1][m][1];
                u32x4 w; w.x = cvt_pk_bf16(v0[0], v0[1]); w.y = cvt_pk_bf16(v0[2], v0[3]); w.z = cvt_pk_bf16(v1[0], v1[1]); w.w = cvt_pk_bf16(v1[2], v1[3]);
                *(u32x4*)(O + (size_t)(row0 + ai * HALF + m * 16) * 512 + col0) = w; }
    }
};

template <class Epi, class Sched, bool ALIGN_EPI, bool GATHER>
__device__ __forceinline__ void gemm_phase(LAS unsigned char* lds, const Gemm g, const Sched& S, const Epi& E) {
    const int tid = threadIdx.x, wid = __builtin_amdgcn_readfirstlane(tid >> 6), lane = tid & 63, wr = wid >> 2, wc = wid & 3, fr = lane & 15, fq = lane >> 4;
    const int K = g.K, nt = K / BK;
    int Rst[2], Cst[2]; unsigned voffB[2];
#pragma unroll
    for (int i = 0; i < 2; ++i) { int R, C; stage_rc(tid * 16 + i * 8192, R, C); const int Rb = Epi::PERM ? ((R & ~31) + perm32(R & 31)) : R;
        Rst[i] = R; Cst[i] = C; voffB[i] = (unsigned)(Rb * K + C) * 2u; }
    const size_t kstep = (size_t)(BK * 2);
    const size_t hstep = (size_t)HALF * K * 2;
    const size_t tstep = 2 * hstep;
    const unsigned ldsw = (unsigned)wid * 1024u;
    const int aoff = lds_byte(wr * 64 + fr, fq * 8), boff = lds_byte(wc * 32 + fr, fq * 8);
#define PG8_SA(b, h) (((b) * 2 + (h)) * HTB)
#define PG8_SB(b, h) ((4 + (b) * 2 + (h)) * HTB)
#define PG8_STAGE(bufoff, gbase, voff) do { _Pragma("unroll") for (int _i = 0; _i < 2; ++_i) \
        __builtin_amdgcn_global_load_lds((const unsigned*)((const char*)(gbase) + (voff)[_i]), (LAS unsigned*)(lds + (bufoff) + ldsw + _i * 8192), 16, 0, 0); } while (0)
#define PG8_LDA(dst, b, h) do { _Pragma("unroll") for (int m = 0; m < 4; ++m) _Pragma("unroll") for (int k = 0; k < 2; ++k) dst[m][k] = *(const LAS bf16x8*)(lds + PG8_SA(b, h) + aoff + m * 2048 + k * 1024); } while (0)
#define PG8_LDB(dst, b, h) do { _Pragma("unroll") for (int n = 0; n < 2; ++n) _Pragma("unroll") for (int k = 0; k < 2; ++k) dst[n][k] = *(const LAS bf16x8*)(lds + PG8_SB(b, h) + boff + n * 2048 + k * 1024); } while (0)
#define PG8_MMA(ai, bj, At, Bt) do { __builtin_amdgcn_s_setprio(1); _Pragma("unroll") for (int m = 0; m < 4; ++m) _Pragma("unroll") for (int n = 0; n < 2; ++n) _Pragma("unroll") for (int k = 0; k < 2; ++k) \
        acc[ai][bj][m][n] = __builtin_amdgcn_mfma_f32_16x16x32_bf16(Bt[n][k], At[m][k], acc[ai][bj][m][n], 0, 0, 0); __builtin_amdgcn_s_setprio(0); } while (0)
#define PG8_WAIT_V(n) asm volatile("s_waitcnt vmcnt(" #n ")" ::: "memory")
#define PG8_WAIT_L(n) asm volatile("s_waitcnt lgkmcnt(" #n ")" ::: "memory")
#define PG8_BAR __builtin_amdgcn_s_barrier()
#define PG8_SCHED __builtin_amdgcn_sched_barrier(0)
#define PG8_VOA(vo, un) do { _Pragma("unroll") for (int _h = 0; _h < 2; ++_h) _Pragma("unroll") for (int _i = 0; _i < 2; ++_i) { \
        if constexpr (GATHER) { const int _r = _h * HALF + Rst[_i]; const int _row = (_r < (un).nvalid) ? (un).rowmap[_r] : 0; vo[_h][_i] = (unsigned)(_row * K + Cst[_i]) * 2u; } \
        else vo[_h][_i] = (unsigned)(Rst[_i] * K + Cst[_i]) * 2u + (unsigned)(_h * hstep); } } while (0)
    Unit cur, nxt; int ui = 0;
    if (!S.next(0, cur)) return;
    f32x4 acc[2][2][4][2];
#pragma unroll
    for (int a = 0; a < 2; ++a)
#pragma unroll
        for (int b = 0; b < 2; ++b)
#pragma unroll
            for (int m = 0; m < 4; ++m)
#pragma unroll
                for (int n = 0; n < 2; ++n) acc[a][b][m][n] = (f32x4){0.f, 0.f, 0.f, 0.f};
    bf16x8 At[4][2], B0[2][2], B1[2][2];
    unsigned voA[2][2], voN[2][2];
    PG8_VOA(voA, cur);
    const char* cA = GATHER ? (const char*)g.A : (const char*)g.A + (size_t)cur.pm * tstep;
    const char* cB = (const char*)g.Bt + ((size_t)cur.e * g.bstride) * 2 + (size_t)cur.pn * tstep;
    PG8_STAGE(PG8_SB(0, 0), cB, voffB); PG8_STAGE(PG8_SB(0, 1), cB + hstep, voffB); PG8_STAGE(PG8_SA(0, 0), cA, voA[0]); PG8_STAGE(PG8_SA(0, 1), cA, voA[1]);
    if (wr == 1) PG8_BAR;
    PG8_WAIT_V(2); PG8_BAR;
    PG8_STAGE(PG8_SB(1, 0), cB + kstep, voffB); PG8_STAGE(PG8_SA(1, 0), cA + kstep, voA[0]); PG8_STAGE(PG8_SB(1, 1), cB + hstep + kstep, voffB);
    PG8_WAIT_V(6); PG8_BAR;
    for (;;) {
        const bool has_next = S.next(ui + 1, nxt);
        const char* nA = cA; const char* nB = cB;
        if (has_next) { nA = GATHER ? (const char*)g.A : (const char*)g.A + (size_t)nxt.pm * tstep; nB = (const char*)g.Bt + ((size_t)nxt.e * g.bstride) * 2 + (size_t)nxt.pn * tstep; PG8_VOA(voN, nxt); }
        else {
#pragma unroll
            for (int _h = 0; _h < 2; ++_h)
#pragma unroll
                for (int _i = 0; _i < 2; ++_i) voN[_h][_i] = voA[_h][_i]; }
        for (int t = 0; t < nt; t += 2) {
            const bool last = (t == nt - 2);
            const char* a1 = cA + (size_t)(t + 1) * kstep;
            const char* a2 = last ? nA : cA + (size_t)(t + 2) * kstep; const char* b2 = last ? nB : cB + (size_t)(t + 2) * kstep;
            const char* a3 = a2 + kstep; const char* b3 = b2 + kstep;
            unsigned vo2[2][2];
#pragma unroll
            for (int _h = 0; _h < 2; ++_h)
#pragma unroll
                for (int _i = 0; _i < 2; ++_i) vo2[_h][_i] = last ? voN[_h][_i] : voA[_h][_i];
            PG8_LDB(B0, 0, 0); PG8_LDB(B1, 0, 1); PG8_SCHED; PG8_LDA(At, 0, 0); PG8_STAGE(PG8_SA(1, 1), a1, voA[1]);
            PG8_WAIT_V(8); PG8_WAIT_L(0); PG8_BAR; PG8_MMA(0, 0, At, B0); PG8_MMA(0, 1, At, B1); PG8_BAR; PG8_SCHED;
            PG8_LDA(At, 0, 1); PG8_STAGE(PG8_SB(0, 0), b2, voffB); PG8_STAGE(PG8_SB(0, 1), b2 + hstep, voffB); PG8_STAGE(PG8_SA(0, 0), a2, vo2[0]);
            PG8_WAIT_V(8); PG8_WAIT_L(0); PG8_BAR; PG8_MMA(1, 0, At, B0); PG8_MMA(1, 1, At, B1); PG8_BAR; PG8_SCHED;
            PG8_LDB(B0, 1, 0); PG8_LDB(B1, 1, 1); PG8_SCHED; PG8_LDA(At, 1, 0); PG8_STAGE(PG8_SA(0, 1), a2, vo2[1]);
            PG8_WAIT_V(8); PG8_WAIT_L(0); PG8_BAR; PG8_MMA(0, 0, At, B0); PG8_MMA(0, 1, At, B1); PG8_BAR; PG8_SCHED;
            PG8_LDA(At, 1, 1); PG8_STAGE(PG8_SB(1, 0), b3, voffB); PG8_STAGE(PG8_SB(1, 1), b3 + hstep, voffB); PG8_STAGE(PG8_SA(1, 0), a3, vo2[0]);
            PG8_WAIT_V(8); PG8_WAIT_L(0); PG8_BAR; PG8_MMA(1, 0, At, B0); PG8_MMA(1, 1, At, B1); PG8_BAR; PG8_SCHED;
        }
        if constexpr (ALIGN_EPI) { if (wr == 0) PG8_BAR; }
        E(acc, cur, wr, wc, fr, fq);
        if (!has_next) break;
#pragma unroll
        for (int a = 0; a < 2; ++a)
#pragma unroll
            for (int b = 0; b < 2; ++b)
#pragma unroll
                for (int m = 0; m < 4; ++m)
#pragma unroll
                    for (int n = 0; n < 2; ++n) acc[a][b][m][n] = (f32x4){0.f, 0.f, 0.f, 0.f};
        cur = nxt; cA = nA; cB = nB; ++ui;
#pragma unroll
        for (int _h = 0; _h < 2; ++_h)
#pragma unroll
            for (int _i = 0; _i < 2; ++_i) voA[_h][_i] = voN[_h][_i];
        if constexpr (ALIGN_EPI) { if (wr == 1) PG8_BAR; }
    }
    PG8_WAIT_V(0);
    if constexpr (!ALIGN_EPI) { if (wr == 0) PG8_BAR; }
    PG8_BAR;
#undef PG8_SA
#undef PG8_SB
#undef PG8_STAGE
#undef PG8_LDA
#undef PG8_LDB
#undef PG8_MMA
#undef PG8_WAIT_V
#undef PG8_WAIT_L
#undef PG8_BAR
#undef PG8_SCHED
#undef PG8_VOA
}
}

namespace att {
typedef short v4i16 __attribute__((ext_vector_type(4)));
__device__ __forceinline__ int crow(int r, int hi) { return (r & 3) + 8 * (r >> 2) + 4 * hi; }
__device__ __forceinline__ bf16x8 vtr2(const LAS unsigned char* p) {
    const v4i16 lo = __builtin_amdgcn_ds_read_tr16_b64_v4i16((LAS v4i16*)p), hi = __builtin_amdgcn_ds_read_tr16_b64_v4i16((LAS v4i16*)(p + 512));
    return (bf16x8){lo[0], lo[1], lo[2], lo[3], hi[0], hi[1], hi[2], hi[3]};
}
__device__ __forceinline__ bf16x8 pack8(const f32x16& p, int b) {
    u32x4 w; w.x = cvt_pk_bf16(p[b], p[b + 1]); w.y = cvt_pk_bf16(p[b + 2], p[b + 3]); w.z = cvt_pk_bf16(p[b + 4], p[b + 5]); w.w = cvt_pk_bf16(p[b + 6], p[b + 7]);
    return __builtin_bit_cast(bf16x8, w);
}
__device__ __forceinline__ float swapmax(float v) { auto rr = __builtin_amdgcn_permlane32_swap(__float_as_uint(v), __float_as_uint(v), false, false); return fmaxf(__uint_as_float(rr[0]), __uint_as_float(rr[1])); }
__device__ __forceinline__ float swapsum(float v) { auto rr = __builtin_amdgcn_permlane32_swap(__float_as_uint(v), __float_as_uint(v), false, false); return __uint_as_float(rr[0]) + __uint_as_float(rr[1]); }
#ifdef DBG_NO_DMA
#define GLDS16(g, l) (*(LAS u32x4*)((l) + (threadIdx.x & 63) * 16) = *(const u32x4*)(g))
#else
#define GLDS16(g, l) __builtin_amdgcn_global_load_lds((const unsigned*)(g), (LAS unsigned*)(l), 16, 0, 0)
#endif

constexpr float DA_THR = 8.f;
__device__ __forceinline__ void da_unit(LAS unsigned char* lds, const bf16_t* proj, bf16_t* mix, int b, int h, int qb, float lam, const float* gainp) {
    const int tid = threadIdx.x, lane = tid & 63, wid = __builtin_amdgcn_readfirstlane(tid >> 6), r32 = lane & 31, hi = lane >> 5;
    const int rg = wid & 3, c = wid >> 2;
    const size_t rowbase = (size_t)b * T_;
    const int i0w = qb * 128 + rg * 32;
    const float slope2 = exp2f(-2.f * (float)(h + 1)) * LOG2E;
    LAS float* wsf = (LAS float*)(lds + 65536) + wid * 64;
    bf16x8 qf[4];
    { const bf16_t* qp = proj + (rowbase + i0w + r32) * P0 + h * 128 + c * 64 + hi * 8;
#pragma unroll
      for (int s = 0; s < 4; ++s) qf[s] = *(const bf16x8*)(qp + s * 16); }
    f32x16 o[4];
#pragma unroll
    for (int d = 0; d < 4; ++d)
#pragma unroll
        for (int r = 0; r < 16; ++r) o[d][r] = 0.f;
    float mrun = -1e30f, lrun = 0.f;
    const int nt = 2 * qb + 2;
    const bf16_t* ksrc[2]; const bf16_t* vsrc[2];
    { const int key = tid >> 3, chp = tid & 7;
#pragma unroll
      for (int i = 0; i < 2; ++i) ksrc[i] = proj + (rowbase + key) * P0 + 512 + h * 128 + i * 64 + ((chp ^ (key & 7)) * 8);
      const int ks = (tid >> 6) & 3, sub = (tid >> 5) & 1, row = (tid >> 2) & 7, cq = tid & 3, vkey = ks * 16 + sub * 8 + row;
#pragma unroll
      for (int i = 0; i < 2; ++i) vsrc[i] = proj + (rowbase + vkey) * P0 + 1024 + h * 128 + (i * 2 + (tid >> 8)) * 32 + cq * 8; }
    const unsigned ldsw = (unsigned)wid * 1024u;
#define DA_ISSUE(jt, sb) do { const size_t _o = (size_t)(jt) * 64 * P0; \
        GLDS16(ksrc[0] + _o, lds + (sb) * 32768 + ldsw); GLDS16(ksrc[1] + _o, lds + (sb) * 32768 + 8192 + ldsw); \
        GLDS16(vsrc[0] + _o, lds + (sb) * 32768 + 16384 + ldsw); GLDS16(vsrc[1] + _o, lds + (sb) * 32768 + 24576 + ldsw); } while (0)
    const int koff = c * 8192 + r32 * 128, kx = r32 & 7;
    const int voff = 16384 + ((lane >> 4) & 1) * 32 + (lane & 3) * 8 + (4 * hi + ((lane & 15) >> 2)) * 64;
    DA_ISSUE(nt - 1, 0);
    __syncthreads();
    for (int it = 0; it < nt; ++it) {
        const int jt = nt - 1 - it, sb = it & 1;
        if (it + 1 < nt) DA_ISSUE(jt - 1, sb ^ 1);
        const int j0 = jt * 64, dj = j0 - i0w;
        if (dj <= 31) {
            const LAS unsigned char* kb = lds + sb * 32768 + koff;
            f32x16 p0, p1;
            const float bbase = slope2 * (float)(dj + 4 * hi);
#pragma unroll
            for (int r = 0; r < 16; ++r) { p0[r] = fmaf(slope2, (float)((r & 3) + 8 * (r >> 2)), bbase); p1[r] = p0[r] + 32.f * slope2; }
#pragma unroll
            for (int s = 0; s < 4; ++s) {
                const bf16x8 ka = *(const LAS bf16x8*)(kb + (((2 * s + hi) ^ kx) << 4));
                const bf16x8 kb2 = *(const LAS bf16x8*)(kb + 4096 + (((2 * s + hi) ^ kx) << 4));
                p0 = __builtin_amdgcn_mfma_f32_32x32x16_bf16(ka, qf[s], p0, 0, 0, 0);
                p1 = __builtin_amdgcn_mfma_f32_32x32x16_bf16(kb2, qf[s], p1, 0, 0, 0);
            }
            if (dj + 63 > 0) {
#pragma unroll
                for (int r = 0; r < 16; ++r) { const int kk = dj + (r & 3) + 8 * (r >> 2) + 4 * hi; if (kk > r32) p0[r] = -INFINITY; if (kk + 32 > r32) p1[r] = -INFINITY; }
            }
            float mx = fmaxf(p0[0], p1[0]);
#pragma unroll
            for (int r = 1; r < 16; ++r) mx = fmaxf(mx, fmaxf(p0[r], p1[r]));
            mx = swapmax(mx);
            if (__any(mx > mrun + DA_THR)) {
                const float mn = fmaxf(mrun, mx), f = fexp2(mrun - mn);
                lrun *= f; mrun = mn;
                if (hi == 0) wsf[r32] = f;
#pragma unroll
                for (int r = 0; r < 16; ++r) { const float fr = wsf[crow(r, hi)];
#pragma unroll
                    for (int d = 0; d < 4; ++d) o[d][r] *= fr; }
            }
            float sum = 0.f;
#pragma unroll
            for (int r = 0; r < 16; ++r) { p0[r] = fexp2(p0[r] - mrun); p1[r] = fexp2(p1[r] - mrun); sum += p0[r] + p1[r]; }
            lrun += sum;
            bf16x8 pa[4];
            pa[0] = pack8(p0, 0); pa[1] = pack8(p0, 8); pa[2] = pack8(p1, 0); pa[3] = pack8(p1, 8);
            const LAS unsigned char* vb = lds + sb * 32768 + voff;
#pragma unroll
            for (int d = 0; d < 4; ++d)
#pragma unroll
                for (int s = 0; s < 4; ++s) { const bf16x8 vf = vtr2(vb + d * 4096 + s * 1024);
                    o[d] = __builtin_amdgcn_mfma_f32_32x32x16_bf16(pa[s], vf, o[d], 0, 0, 0); }
        }
        __syncthreads();
    }
#undef DA_ISSUE
    const float lt = swapsum(lrun);
    if (hi == 0) wsf[r32] = (c == 0 ? 1.f : lam) / lt;
    LAS float* xch = (LAS float*)lds + rg * 4096 + lane;
#pragma unroll
    for (int r = 0; r < 16; ++r) { const float cf = wsf[crow(r, hi)];
#pragma unroll
        for (int d = 0; d < 4; ++d) { o[d][r] *= cf; if (c == 1) xch[(d * 16 + r) * 64] = o[d][r]; } }
    __syncthreads();
    if (c == 0) {
        float ssq[16];
#pragma unroll
        for (int r = 0; r < 16; ++r) { float q = 0.f;
#pragma unroll
            for (int d = 0; d < 4; ++d) { const float v = o[d][r] - xch[(d * 16 + r) * 64]; o[d][r] = v; q += v * v; }
            ssq[r] = q; }
#pragma unroll
        for (int r = 0; r < 16; ++r) {
#pragma unroll
            for (int off = 1; off < 32; off <<= 1) ssq[r] += __shfl_xor(ssq[r], off);
            ssq[r] = (1.f - LAM_INIT0) / sqrtf(ssq[r] * (1.f / 128.f) + RMS_EPS); }
        float gn[4];
#pragma unroll
        for (int d = 0; d < 4; ++d) gn[d] = gainp[d * 32 + r32];
#pragma unroll
        for (int r = 0; r < 16; ++r) { bf16_t* orow = mix + (rowbase + i0w + crow(r, hi)) * D_ + h * 128 + r32;
#pragma unroll
            for (int d = 0; d < 4; ++d) orow[d * 32] = f2bf(o[d][r] * ssq[r] * gn[d]); }
    }
    __syncthreads();
}
__device__ __forceinline__ void ph_diffattn(const Ptrs& P, LAS unsigned char* lds, int vcu, int G) {
    const int lane = threadIdx.x & 63;
    const float* dl = P.in[8];
    const float d01 = wave_sum(dl[lane] * dl[64 + lane]), d23 = wave_sum(dl[128 + lane] * dl[192 + lane]);
    const float lam = expf(d01) - expf(d23) + LAM_INIT0;
    for (int u = vcu; u < 256; u += G) {
        const int bh = u >> 3, s = u & 7;
        for (int k = 0; k < 4; ++k) { const int qb = (k == 0) ? s : (k == 1) ? 15 - s : (k == 2) ? 16 + s : 31 - s;
            da_unit(lds, (const bf16_t*)(P.ws + WS_P), (bf16_t*)(P.ws + WS_H), bh >> 2, bh & 3, qb, lam, P.in[9]); }
    }
}

#ifndef SB_EXIT
#define SB_EXIT 1e-30f
#endif
__device__ __forceinline__ void sb_unit(LAS unsigned char* lds, const bf16_t* proj, bf16_t* mix, int b, int h, int qb) {
    const int tid = threadIdx.x, lane = tid & 63, wid = __builtin_amdgcn_readfirstlane(tid >> 6), r32 = lane & 31, hi = lane >> 5;
    const size_t rowbase = (size_t)b * T_;
    const int i0w = qb * 256 + wid * 32;
    LAS float* flg = (LAS float*)(lds + 32768);
    bf16x8 qf[4];
    { const bf16_t* qp = proj + (rowbase + i0w + r32) * P1 + 1024 + h * 64 + hi * 8;
#pragma unroll
      for (int s = 0; s < 4; ++s) qf[s] = *(const bf16x8*)(qp + s * 16); }
    f32x16 o[2];
#pragma unroll
    for (int d = 0; d < 2; ++d)
#pragma unroll
        for (int r = 0; r < 16; ++r) o[d][r] = 0.f;
    float Rrun = 1.f;
    const int nt = 4 * qb + 4;
    const bf16_t* ksrc; const bf16_t* vsrc;
    { const int key = tid >> 3, chp = tid & 7;
      ksrc = proj + (rowbase + key) * P1 + 1536 + h * 64 + ((chp ^ (key & 7)) * 8);
      const int ks = (tid >> 6) & 3, sub = (tid >> 5) & 1, row = (tid >> 2) & 7, cq = tid & 3, vkey = ks * 16 + sub * 8 + row;
      vsrc = proj + (rowbase + vkey) * P1 + 2048 + h * 64 + (tid >> 8) * 32 + cq * 8; }
    const unsigned ldsw = (unsigned)wid * 1024u;
#define SB_ISSUE(jt, sb) do { const size_t _o = (size_t)(jt) * 64 * P1; GLDS16(ksrc + _o, lds + (sb) * 16384 + ldsw); GLDS16(vsrc + _o, lds + (sb) * 16384 + 8192 + ldsw); } while (0)
    const int koff = r32 * 128, kx = r32 & 7;
    const int voff = 8192 + ((lane >> 4) & 1) * 32 + (lane & 3) * 8 + (4 * hi + ((lane & 15) >> 2)) * 64;
    SB_ISSUE(nt - 1, 0);
    __syncthreads();
    for (int it = 0; it < nt; ++it) {
        const int jt = nt - 1 - it, sb = it & 1;
        if (it + 1 < nt) SB_ISSUE(jt - 1, sb ^ 1);
        const int j0 = jt * 64, dj = j0 - i0w;
        if (dj <= 30) {
            const LAS unsigned char* kb = lds + sb * 16384 + koff;
            f32x16 p0, p1;
#pragma unroll
            for (int r = 0; r < 16; ++r) { p0[r] = 0.f; p1[r] = 0.f; }
#pragma unroll
            for (int s = 0; s < 4; ++s) {
                const bf16x8 ka = *(const LAS bf16x8*)(kb + (((2 * s + hi) ^ kx) << 4));
                const bf16x8 kb2 = *(const LAS bf16x8*)(kb + 4096 + (((2 * s + hi) ^ kx) << 4));
                p0 = __builtin_amdgcn_mfma_f32_32x32x16_bf16(ka, qf[s], p0, 0, 0, 0);
                p1 = __builtin_amdgcn_mfma_f32_32x32x16_bf16(kb2, qf[s], p1, 0, 0, 0);
            }
            f32x16 q0, q1;
#pragma unroll
            for (int r = 0; r < 16; ++r) {
                const float e0 = fexp2(fminf(p0[r], 80.f)), e1 = fexp2(fminf(p1[r], 80.f));
                q0[r] = frcp(1.f + e0); q1[r] = frcp(1.f + e1); p0[r] = e0 * q0[r]; p1[r] = e1 * q1[r]; }
            if (dj + 63 >= 0) {
#pragma unroll
                for (int r = 0; r < 16; ++r) { const int kk = dj + (r & 3) + 8 * (r >> 2) + 4 * hi;
                    if (kk >= r32) { p0[r] = 0.f; q0[r] = 1.f; } if (kk + 32 >= r32) { p1[r] = 0.f; q1[r] = 1.f; } }
            }
            float Gown[8], Goth[8], Tsuf[8];
#pragma unroll
            for (int g = 0; g < 4; ++g) { Gown[g] = (q0[4 * g] * q0[4 * g + 1]) * (q0[4 * g + 2] * q0[4 * g + 3]); Gown[4 + g] = (q1[4 * g] * q1[4 * g + 1]) * (q1[4 * g + 2] * q1[4 * g + 3]); }
#pragma unroll
            for (int g = 0; g < 8; ++g) Goth[g] = swapother(Gown[g], hi);
            Tsuf[7] = 1.f;
#pragma unroll
            for (int g = 6; g >= 0; --g) Tsuf[g] = Tsuf[g + 1] * (Gown[g + 1] * Goth[g + 1]);
            const float tot = Tsuf[0] * (Gown[0] * Goth[0]);
#pragma unroll
            for (int g = 0; g < 4; ++g) {
                const float f0 = Rrun * Tsuf[g] * (hi ? 1.f : Goth[g]), f1 = Rrun * Tsuf[4 + g] * (hi ? 1.f : Goth[4 + g]);
                const float a3 = q0[4 * g + 3], a2 = a3 * q0[4 * g + 2], a1 = a2 * q0[4 * g + 1];
                p0[4 * g + 3] *= f0; p0[4 * g + 2] *= f0 * a3; p0[4 * g + 1] *= f0 * a2; p0[4 * g] *= f0 * a1;
                const float b3 = q1[4 * g + 3], b2 = b3 * q1[4 * g + 2], b1 = b2 * q1[4 * g + 1];
                p1[4 * g + 3] *= f1; p1[4 * g + 2] *= f1 * b3; p1[4 * g + 1] *= f1 * b2; p1[4 * g] *= f1 * b1;
            }
            Rrun *= tot;
            bf16x8 pa[4];
            pa[0] = pack8(p0, 0); pa[1] = pack8(p0, 8); pa[2] = pack8(p1, 0); pa[3] = pack8(p1, 8);
            const LAS unsigned char* vb = lds + sb * 16384 + voff;
#pragma unroll
            for (int d = 0; d < 2; ++d)
#pragma unroll
                for (int s = 0; s < 4; ++s) { const bf16x8 vf = vtr2(vb + d * 4096 + s * 1024);
                    o[d] = __builtin_amdgcn_mfma_f32_32x32x16_bf16(pa[s], vf, o[d], 0, 0, 0); }
        }
        { const float wm = wave_max(Rrun); if (lane == 0) flg[sb * 8 + wid] = wm; }
        __syncthreads();
        { float mxr = flg[sb * 8];
#pragma unroll
          for (int w = 1; w < 8; ++w) mxr = fmaxf(mxr, flg[sb * 8 + w]);
          if (mxr < SB_EXIT) break; }
    }
#undef SB_ISSUE
    __syncthreads();
#pragma unroll
    for (int r = 0; r < 16; ++r) { bf16_t* orow = mix + (rowbase + i0w + crow(r, hi)) * D_ + 512 + h * 64 + r32;
#pragma unroll
        for (int d = 0; d < 2; ++d) orow[d * 32] = f2bf(o[d][r]); }
}
__device__ __forceinline__ void ph_sbattn(const Ptrs& P, LAS unsigned char* lds, int vcu, int G) {
    for (int u = vcu; u < 256; u += G) {
        const int bh = u >> 2, s = u & 3;
        for (int k = 0; k < 4; ++k) { const int qb = (k == 0) ? s : (k == 1) ? 7 - s : (k == 2) ? 8 + s : 15 - s;
            sb_unit(lds, (const bf16_t*)(P.ws + WS_P), (bf16_t*)(P.ws + WS_H), bh >> 3, bh & 7, qb); }
    }
}
}

namespace hg {
constexpr int QM = 0, KM = 17408, QB = 34816, KDT = 52224, VT = 70656, ATT = 89088, DEC = 98304, TOT = 98816, OO = 0;
constexpr int PQ = 272, PT = 144, PO = 528;
typedef float f32x4v __attribute__((ext_vector_type(4)));
__device__ __forceinline__ f32x4 mma16(bf16x8 a, bf16x8 b, f32x4 c) { return __builtin_amdgcn_mfma_f32_16x16x32_bf16(a, b, c, 0, 0, 0); }
template <bool STATS>
__device__ __forceinline__ void hg_unit(LAS unsigned char* lds, const Ptrs& P, int u) {
    const int tid = threadIdx.x, lane = tid & 63, wid = __builtin_amdgcn_readfirstlane(tid >> 6), l15 = lane & 15, g = lane >> 4;
    const int bh = u >> 3, seg = u & 7, b = bh >> 2, h = bh & 3;
    const bf16_t* proj = (const bf16_t*)(P.ws + WS_P);
    bf16_t* mix = (bf16_t*)(P.ws + WS_H);
    float* HGS = (float*)(P.ws + WS_HGS); float* HGD = (float*)(P.ws + WS_HGD);
    const int col = tid & 127, qtr = tid >> 7;
    float lb;
    { const float* gam = P.in[10]; const int c = h * 128 + col; const float g0 = gam[c], g1 = gam[512 + c], g2 = gam[1024 + c]; const float mx = fmaxf(g0, fmaxf(g1, g2));
      const float e0 = expf(g0 - mx), e1 = expf(g1 - mx), e2 = expf(g2 - mx); lb = e0 / (e0 + e1 + e2); }
    f32x4 S[8];
#pragma unroll
    for (int k = 0; k < 8; ++k) S[k] = (f32x4){0.f, 0.f, 0.f, 0.f};
    if (!STATS) {
        for (int j = 0; j < seg; ++j) { const int uj = bh * 8 + j;
            const f32x4* sp = (const f32x4*)(HGS + (size_t)uj * 16384) + (wid * 8) * 64 + lane; const float* dp = HGD + (size_t)uj * 128;
#pragma unroll
            for (int k = 0; k < 8; ++k) { const f32x4 d = *(const f32x4*)(dp + 16 * k + 4 * g); S[k] = S[k] * d + sp[k * 64]; } }
    }
    float sumlog = 0.f;
    for (int ch = 0; ch < 8; ++ch) {
        const size_t row0 = (size_t)b * T_ + seg * 512 + ch * 64 + qtr * 16;
        float cs[16], kk[16], qv[16], vv[16];
        { const bf16_t* pr = proj + row0 * P0 + h * 128 + col; float run = 0.f;
#pragma unroll
          for (int i = 0; i < 16; ++i) { const bf16_t* r = pr + (size_t)i * P0;
              const float fl = bf2f(r[2048]); const float f = lb + (1.f - lb) * sigmoidf_(fl);
              run += __builtin_amdgcn_logf(f) * LN2F; cs[i] = run; kk[i] = 1.f - f; vv[i] = bf2f(r[2560]); if (!STATS) qv[i] = bf2f(r[1536]); } }
        ((LAS float*)(lds + TOT))[qtr * 128 + col] = cs[15];
        __syncthreads();
        { const LAS float* tp = (const LAS float*)(lds + TOT) + col; const float t0 = tp[0], t1 = tp[128], t2 = tp[256], t3 = tp[384];
          const float off = (qtr > 0 ? t0 : 0.f) + (qtr > 1 ? t1 : 0.f) + (qtr > 2 ? t2 : 0.f), bmid = t0 + t1, blast = (t0 + t1) + (t2 + t3);
          const float emid = fexp(bmid), elm = fexp(blast - bmid);
          if (qtr == 0) { ((LAS float*)(lds + DEC))[col] = fexp(blast); sumlog += blast; }
#pragma unroll
          for (int i = 0; i < 16; ++i) { const int tok = qtr * 16 + i; const float bb = cs[i] + off; const float e1 = fexp(bb - bmid), e2 = frcp(e1);
              *(LAS bf16_t*)(lds + KDT + col * PT + tok * 2) = f2bf(kk[i] * e2 * elm);
              *(LAS bf16_t*)(lds + VT + col * PT + tok * 2) = f2bf(vv[i]);
              if (!STATS) { *(LAS bf16_t*)(lds + QM + tok * PQ + col * 2) = f2bf(qv[i] * e1); *(LAS bf16_t*)(lds + KM + tok * PQ + col * 2) = f2bf(kk[i] * e2);
                  *(LAS bf16_t*)(lds + QB + tok * PQ + col * 2) = f2bf(qv[i] * e1 * emid); } } }
        __syncthreads();
        f32x4 ao[4];
        if (!STATS) {
#pragma unroll
            for (int rep = 0; rep < 2; ++rep) { const int ti = wid + 8 * rep;
                if (ti < 10) { const int cb = ti < 1 ? 0 : ti < 3 ? 1 : ti < 6 ? 2 : 3; const int sb = ti - (cb * (cb + 1)) / 2;
                    f32x4 acc = (f32x4){0.f, 0.f, 0.f, 0.f};
#pragma unroll
                    for (int st = 0; st < 4; ++st) { const bf16x8 a = *(const LAS bf16x8*)(lds + QM + (16 * cb + l15) * PQ + (32 * st + 8 * g) * 2), bb = *(const LAS bf16x8*)(lds + KM + (16 * sb + l15) * PQ + (32 * st + 8 * g) * 2);
                        acc = mma16(a, bb, acc); }
#pragma unroll
                    for (int r = 0; r < 4; ++r) { float v = acc[r]; if (cb == sb && 4 * g + r < l15) v = 0.f; *(LAS bf16_t*)(lds + ATT + (16 * cb + 4 * g + r) * PT + (16 * sb + l15) * 2) = f2bf(v); } }
                else if (rep == 1 && wid >= 2) { const int zi = wid - 2; const int cb = zi < 3 ? 0 : zi < 5 ? 1 : 2; const int sb = zi < 3 ? zi + 1 : zi < 5 ? zi - 1 : 3;
#pragma unroll
                    for (int r = 0; r < 4; ++r) *(LAS bf16_t*)(lds + ATT + (16 * cb + 4 * g + r) * PT + (16 * sb + l15) * 2) = 0; } }
            bf16x8 Sb[4];
#pragma unroll
            for (int st = 0; st < 4; ++st) { u32x4 w; w.x = cvt_pk_bf16(S[2 * st][0], S[2 * st][1]); w.y = cvt_pk_bf16(S[2 * st][2], S[2 * st][3]); w.z = cvt_pk_bf16(S[2 * st + 1][0], S[2 * st + 1][1]); w.w = cvt_pk_bf16(S[2 * st + 1][2], S[2 * st + 1][3]); Sb[st] = __builtin_bit_cast(bf16x8, w); }
#pragma unroll
            for (int cb = 0; cb < 4; ++cb) { ao[cb] = (f32x4){0.f, 0.f, 0.f, 0.f};
#pragma unroll
                for (int st = 0; st < 4; ++st) { const LAS unsigned char* ap = lds + QB + (16 * cb + l15) * PQ + (32 * st + 4 * g) * 2;
                    const u32x2 lo = *(const LAS u32x2*)ap, hi2 = *(const LAS u32x2*)(ap + 32); const u32x4 w = {lo.x, lo.y, hi2.x, hi2.y};
                    ao[cb] = mma16(__builtin_bit_cast(bf16x8, w), Sb[st], ao[cb]); } }
        }
#pragma unroll
        for (int k = 0; k < 8; ++k) { const f32x4 d = *(const LAS f32x4*)(lds + DEC + (16 * k + 4 * g) * 4); S[k] = S[k] * d;
#pragma unroll
            for (int ks = 0; ks < 2; ++ks) { const bf16x8 a = *(const LAS bf16x8*)(lds + KDT + (16 * k + l15) * PT + (32 * ks + 8 * g) * 2), bb = *(const LAS bf16x8*)(lds + VT + (16 * wid + l15) * PT + (32 * ks + 8 * g) * 2);
                S[k] = mma16(a, bb, S[k]); } }
        __syncthreads();
        if (!STATS) {
#pragma unroll
            for (int cb = 0; cb < 4; ++cb)
#pragma unroll
                for (int ks = 0; ks < 2; ++ks) { const bf16x8 a = *(const LAS bf16x8*)(lds + ATT + (16 * cb + l15) * PT + (32 * ks + 8 * g) * 2), bb = *(const LAS bf16x8*)(lds + VT + (16 * wid + l15) * PT + (32 * ks + 8 * g) * 2);
                    ao[cb] = mma16(a, bb, ao[cb]); }
#pragma unroll
            for (int cb = 0; cb < 4; ++cb)
#pragma unroll
                for (int r = 0; r < 4; ++r) *(LAS float*)(lds + OO + (16 * cb + 4 * g + r) * PO + (16 * wid + l15) * 4) = ao[cb][r];
            __syncthreads();
            { const int row = tid >> 3, sg = tid & 7; const LAS f32x4* op = (const LAS f32x4*)(lds + OO + row * PO + sg * 64);
              f32x4 v[4]; float q = 0.f;
#pragma unroll
              for (int i = 0; i < 4; ++i) { v[i] = op[i]; q += (v[i][0] * v[i][0] + v[i][1] * v[i][1]) + (v[i][2] * v[i][2] + v[i][3] * v[i][3]); }
              q += __shfl_xor(q, 1); q += __shfl_xor(q, 2); q += __shfl_xor(q, 4);
              const float rstd = 1.f / sqrtf(q * (1.f / 128.f) + RMS_EPS);
              const size_t grow = (size_t)b * T_ + seg * 512 + ch * 64 + row;
              const bf16_t* gp = proj + grow * P0 + 3072 + h * 128 + sg * 16; const float* gn = P.in[11] + sg * 16;
              const u32x4 ga = *(const u32x4*)gp, gb = *(const u32x4*)(gp + 8);
              const unsigned gw[8] = {ga.x, ga.y, ga.z, ga.w, gb.x, gb.y, gb.z, gb.w};
              unsigned ow[8];
#pragma unroll
              for (int i = 0; i < 8; ++i) { const float x0 = v[i >> 1][(i & 1) * 2] * rstd * gn[2 * i] * __uint_as_float(gw[i] << 16), x1 = v[i >> 1][(i & 1) * 2 + 1] * rstd * gn[2 * i + 1] * __uint_as_float(gw[i] & 0xffff0000u);
                  ow[i] = cvt_pk_bf16(x0, x1); }
              bf16_t* mp = mix + grow * D_ + 512 + h * 128 + sg * 16;
              *(u32x4*)mp = (u32x4){ow[0], ow[1], ow[2], ow[3]}; *(u32x4*)(mp + 8) = (u32x4){ow[4], ow[5], ow[6], ow[7]}; }
            __syncthreads();
        }
    }
    if (STATS) {
        f32x4* sp = (f32x4*)(HGS + (size_t)u * 16384) + (wid * 8) * 64 + lane;
#pragma unroll
        for (int k = 0; k < 8; ++k) sp[k * 64] = S[k];
        if (qtr == 0) HGD[(size_t)u * 128 + col] = fexp(sumlog);
    }
}
template <bool STATS>
__device__ __forceinline__ void ph_hgrn(const Ptrs& P, LAS unsigned char* lds, int vcu, int G) {
    for (int u = vcu; u < 256; u += G) { hg_unit<STATS>(lds, P, u); __syncthreads(); }
}
}

namespace lru {
constexpr int XR = 0, XCB = 16896, WG = 35328, AL = 53760, UL = 86528, PS = 119296, HS = 121344, HC = 123392, PC = 123648;
constexpr int PX = 144;
template <bool STATS>
__device__ __forceinline__ void lru_unit(LAS unsigned char* lds, const Ptrs& P, int u) {
    const int tid = threadIdx.x, lane = tid & 63, wid = __builtin_amdgcn_readfirstlane(tid >> 6), r32 = lane & 31, hi = lane >> 5;
    const int b = u >> 5, g = (u >> 2) & 7, q = u & 3;
    const bf16_t* proj = (const bf16_t*)(P.ws + WS_P);
    bf16_t* mix = (bf16_t*)(P.ws + WS_H);
    float* ST = (float*)(P.ws + WS_LRU);
    for (int idx = tid; idx < 8192; idx += 512) { const int k = idx >> 7, n = idx & 127;
        const float w = n < 64 ? P.in[16][(size_t)(g * 64 + k) * 64 + n] : P.in[18][(size_t)(g * 64 + k) * 64 + (n - 64)];
        *(LAS bf16_t*)(lds + WG + n * PX + k * 2) = f2bf(w); }
    const int ch = tid & 63, oct = tid >> 6, cg = g * 64 + ch;
    const float w0 = P.in[14][cg], w1 = P.in[14][512 + cg], w2 = P.in[14][1024 + cg], w3 = P.in[14][1536 + cg], cbv = P.in[15][cg];
    const int tb = wid >> 1, chh = wid & 1, chm = chh * 32 + r32, cgm = g * 64 + chm;
    const float bav = P.in[17][cgm], bxv = P.in[19][cgm], spv = softplusf_(-P.in[20][cgm]);
    if (tid < 64) { float c = 0.f;
        if (!STATS) { for (int qq = 0; qq < q; ++qq) { const float* sp = ST + ((size_t)(b * 4 + qq) * 512 + cg) * 2; c = sp[0] * c + sp[1]; } }
        ((LAS float*)(lds + HC))[ch] = c; ((LAS float*)(lds + PC))[ch] = 1.f; }
    __syncthreads();
    for (int sbk = 0; sbk < 8; ++sbk) {
        const int t0 = q * 1024 + sbk * 128;
        for (int idx = tid; idx < 131 * 8; idx += 512) { const int r = idx >> 3, c8 = idx & 7; const int t = t0 - 3 + r;
            u32x4 v = {0u, 0u, 0u, 0u}; if (t >= 0) v = *(const u32x4*)(proj + ((size_t)b * T_ + t) * P1 + g * 64 + c8 * 8);
            *(LAS u32x4*)(lds + XR + r * 128 + c8 * 16) = v; }
        __syncthreads();
#pragma unroll 4
        for (int i = 0; i < 16; ++i) { const int tl = oct * 16 + i; const LAS bf16_t* xp = (const LAS bf16_t*)(lds + XR) + tl * 64 + ch;
            const float xc = w0 * bf2f(xp[0]) + w1 * bf2f(xp[64]) + w2 * bf2f(xp[128]) + w3 * bf2f(xp[192]) + cbv;
            *(LAS bf16_t*)(lds + XCB + tl * PX + ch * 2) = f2bf(xc); }
        __syncthreads();
        { f32x16 ga, gx;
#pragma unroll
          for (int r = 0; r < 16; ++r) { ga[r] = 0.f; gx[r] = 0.f; }
#pragma unroll
          for (int s = 0; s < 4; ++s) { const bf16x8 a = *(const LAS bf16x8*)(lds + XCB + (32 * tb + r32) * PX + (16 * s + 8 * hi) * 2);
              const bf16x8 ba_ = *(const LAS bf16x8*)(lds + WG + chm * PX + (16 * s + 8 * hi) * 2), bx_ = *(const LAS bf16x8*)(lds + WG + (64 + chm) * PX + (16 * s + 8 * hi) * 2);
              ga = __builtin_amdgcn_mfma_f32_32x32x16_bf16(a, ba_, ga, 0, 0, 0); gx = __builtin_amdgcn_mfma_f32_32x32x16_bf16(a, bx_, gx, 0, 0, 0); }
#pragma unroll
          for (int r = 0; r < 16; ++r) { const int t = 32 * tb + (r & 3) + 8 * (r >> 2) + 4 * hi;
              const float xcv = bf2f(*(const LAS bf16_t*)(lds + XCB + t * PX + chm * 2));
              const float rg = sigmoidf_(ga[r] + bav), ig = sigmoidf_(gx[r] + bxv);
              const float la = -8.f * rg * spv, a = fexp(la), x2 = 2.f * la;
              const float om = (x2 > -0.25f) ? -x2 * (1.f + 0.5f * x2 * (1.f + (1.f / 3.f) * x2 * (1.f + 0.25f * x2 * (1.f + 0.2f * x2)))) : 1.f - a * a;
              const float uu = sqrtf(fmaxf(om, 1e-12f)) * (ig * xcv);
              ((LAS float*)(lds + AL))[t * 64 + chm] = a; ((LAS float*)(lds + UL))[t * 64 + chm] = uu; } }
        __syncthreads();
        { float hl = 0.f, pl = 1.f; LAS float* ap = (LAS float*)(lds + AL) + (oct * 16) * 64 + ch; LAS float* up = (LAS float*)(lds + UL) + (oct * 16) * 64 + ch;
#pragma unroll 4
          for (int i = 0; i < 16; ++i) { const float a = ap[i * 64], uu = up[i * 64]; hl = a * hl + uu; pl *= a; up[i * 64] = hl; ap[i * 64] = pl; }
          ((LAS float*)(lds + PS))[oct * 64 + ch] = pl; ((LAS float*)(lds + HS))[oct * 64 + ch] = hl; }
        __syncthreads();
        { float c = ((LAS float*)(lds + HC))[ch]; float pt = 1.f;
#pragma unroll
          for (int o = 0; o < 8; ++o) { const float po = ((LAS float*)(lds + PS))[o * 64 + ch], ho = ((LAS float*)(lds + HS))[o * 64 + ch]; if (o < oct) c = po * c + ho; pt *= po; }
          if (!STATS) { const LAS float* ap = (const LAS float*)(lds + AL) + (oct * 16) * 64 + ch; const LAS float* up = (const LAS float*)(lds + UL) + (oct * 16) * 64 + ch;
              const size_t rowb = (size_t)b * T_ + t0 + oct * 16;
#pragma unroll 4
              for (int i = 0; i < 16; ++i) { const float hh = up[i * 64] + ap[i * 64] * c; const float gr = bf2f(proj[(rowb + i) * P1 + 512 + cg]);
                  mix[(rowb + i) * D_ + cg] = f2bf(gr * hh); } }
          __syncthreads();
          if (oct == 7) { const float po = ((LAS float*)(lds + PS))[7 * 64 + ch], ho = ((LAS float*)(lds + HS))[7 * 64 + ch];
              ((LAS float*)(lds + HC))[ch] = po * c + ho; ((LAS float*)(lds + PC))[ch] *= pt; } }
        __syncthreads();
    }
    if (STATS && tid < 64) { float* sp = ST + ((size_t)(b * 4 + q) * 512 + cg) * 2; sp[0] = ((LAS float*)(lds + PC))[ch]; sp[1] = ((LAS float*)(lds + HC))[ch]; }
    __syncthreads();
}
template <bool STATS>
__device__ __forceinline__ void ph_lru(const Ptrs& P, LAS unsigned char* lds, int vcu, int G) {
    for (int u = vcu; u < 256; u += G) lru_unit<STATS>(lds, P, u);
}
}

#define XB_TMO      128
#define XB_XCNT(j)  (256  + 64 * (j))
#define XB_XSUB(j)  (1280 + 64 * (j))
#define XB_XGEN(j)  (2304 + 64 * (j))
#define XB_TOP      3328
#define XB_TOPGEN   3392
#define XCD_BAR_WORDS 3456
#define XB_SPIN_CAP (1u << 18)
__device__ __forceinline__ unsigned xb_ld(unsigned* p)              { return __hip_atomic_load(p, __ATOMIC_RELAXED, __HIP_MEMORY_SCOPE_AGENT); }
__device__ __forceinline__ unsigned xb_add(unsigned* p, unsigned v) { return __hip_atomic_fetch_add(p, v, __ATOMIC_RELAXED, __HIP_MEMORY_SCOPE_AGENT); }
__device__ __forceinline__ unsigned xb_xcc_id() { return (unsigned)__builtin_amdgcn_s_getreg((3 << 11) | 20) & 0xFu; }
#define XB_SPIN(cond, bar) do { unsigned _sp = 0; while (cond) { __builtin_amdgcn_s_sleep(1); \
    if ((++_sp & 255u) == 0u) { if (xb_ld(&(bar)[XB_TMO])) break; if (_sp > XB_SPIN_CAP) { atomicAdd(&(bar)[XB_TMO], 1u); break; } } } } while (0)
struct XcdBarrier { unsigned* bar; unsigned x; volatile LAS unsigned* st; };
__device__ __forceinline__ XcdBarrier xcd_barrier_post(unsigned* bar, volatile LAS unsigned* st) {
    XcdBarrier b; b.bar = bar; b.x = xb_xcc_id(); b.st = st;
    if (threadIdx.x == 0) (void)xb_add(&bar[XB_XCNT(b.x)], 1u);
    return b;
}
__device__ __forceinline__ void xcd_barrier_complete(unsigned* bar, unsigned x, unsigned& nloc, unsigned& nx) {
    const unsigned G = gridDim.x * gridDim.y * gridDim.z;
    unsigned sum, cnt, mine, sp = 0u;
    for (;;) {
        sum = 0u; cnt = 0u; mine = 0u;
#pragma unroll
        for (unsigned j = 0; j < 16; ++j) { const unsigned c = xb_ld(&bar[XB_XCNT(j)]); sum += c; cnt += (c > 0u) ? 1u : 0u; mine = (j == x) ? c : mine; }
        if (sum == G) break;
        __builtin_amdgcn_s_sleep(1);
        if ((++sp & 255u) == 0u) { if (xb_ld(&bar[XB_TMO])) break; if (sp > XB_SPIN_CAP) { atomicAdd(&bar[XB_TMO], 1u); break; } }
    }
    nloc = mine > 0u ? mine : 1u; nx = cnt > 0u ? cnt : 1u;
}
__device__ __forceinline__ void xcd_barrier(const XcdBarrier& b) {
    asm volatile("s_waitcnt vmcnt(0)" ::: "memory");
    __syncthreads();
    if (threadIdx.x == 0) {
        unsigned* bar = b.bar;
        __builtin_amdgcn_s_waitcnt(0);
        unsigned nloc = b.st[0], nx = b.st[1];
        if (nloc == 0u) { xcd_barrier_complete(bar, b.x, nloc, nx); b.st[0] = nloc; b.st[1] = nx; }
        const unsigned old = xb_add(&bar[XB_XSUB(b.x)], 1u);
        const unsigned gen = old / nloc;
        if (old + 1u == (gen + 1u) * nloc) {
            __builtin_amdgcn_fence(__ATOMIC_RELEASE, "agent");
            asm volatile("s_waitcnt vmcnt(0)" ::: "memory");
            const unsigned og = xb_add(&bar[XB_TOP], 1u);
            const unsigned tg = og / nx;
            if (og + 1u == (tg + 1u) * nx) xb_add(&bar[XB_TOPGEN], 1u);
            else XB_SPIN(xb_ld(&bar[XB_TOPGEN]) == tg, bar);
            __builtin_amdgcn_fence(__ATOMIC_ACQUIRE, "agent");
            xb_add(&bar[XB_XGEN(b.x)], 1u);
            asm volatile("s_waitcnt vmcnt(0)" ::: "memory");
        } else {
            XB_SPIN(xb_ld(&bar[XB_XGEN(b.x)]) == gen, bar);
            __builtin_amdgcn_fence(__ATOMIC_ACQUIRE, "agent");
            asm volatile("s_waitcnt vmcnt(0)" ::: "memory");
        }
    }
    __syncthreads();
}

struct Args { Ptrs p; int ph_lo, ph_hi; };
constexpr int LDS_BYTES = 147456;
constexpr int LDS_CTL = 131072;
__device__ __forceinline__ void moe_table(const Ptrs& P, int l, LAS unsigned char* lds) {
    LAS int* tab = (LAS int*)(lds + LDS_CTL);
    __syncthreads();
    if (threadIdx.x == 0) { const unsigned* gcnt = (const unsigned*)(P.ws + WS_CTL) + CW_GCNT + l * 16; int acc = 0;
        for (int e = 0; e < 16; ++e) { const int c = (int)__hip_atomic_load(gcnt + e, __ATOMIC_RELAXED, __HIP_MEMORY_SCOPE_AGENT); tab[e] = acc; tab[32 + e] = c; acc += (c + 255) >> 8; }
        tab[16] = acc; }
    __syncthreads();
}
#ifndef REP_DENSE
#define REP_DENSE 1
#endif
#ifndef REP_MOE
#define REP_MOE 1
#endif
#ifndef REP_DA
#define REP_DA 1
#endif
#ifndef REP_HG
#define REP_HG 1
#endif
#ifndef REP_LRU
#define REP_LRU 1
#endif
#ifndef REP_SB
#define REP_SB 1
#endif
#ifndef REP_PRO
#define REP_PRO 1
#endif
#define RUNREP(REP, ...) do { __VA_ARGS__; if (REP > 1) { xcd_barrier(bar); __VA_ARGS__; } } while (0)
template <int l>
__device__ __forceinline__ void layer_phases(const Args& a, LAS unsigned char* lds, int lo, int hi, int G, int bx, int vcu, const XcdBarrier& bar) {
#define IN(k) (lo <= (k) && (k) < hi)
#define BAR(k) do { if (lo <= (k) && (k) + 1 < hi) xcd_barrier(bar); } while (0)
    unsigned char* ws = a.p.ws;
    constexpr int pb = 2 + 8 * l;
    if (IN(pb + 0)) {
        constexpr int N = l == 0 ? P0 : P1;
        pg8::Gemm g{(const bf16_t*)(ws + WS_H), (const bf16_t*)(ws + (l == 0 ? WS_WINE : WS_WINO)), 1024, 0};
        pg8::StaticOrder S; S.init(M_, N, G, bx);
        constexpr unsigned long long modes = l == 0 ? (0x11ull | (0x22ull << 24) | (0x22ull << 48)) : ((0x33ull << 8) | (0x11ull << 16));
        pg8::EpiAct E{(bf16_t*)(ws + WS_P), N, modes, QSC};
        RUNREP(REP_DENSE, pg8::gemm_phase<pg8::EpiAct, pg8::StaticOrder, true, false>(lds, g, S, E));
    }
    BAR(pb + 0);
    if (IN(pb + 1)) { if constexpr (l == 0) RUNREP(REP_HG, hg::ph_hgrn<true>(a.p, lds, vcu, G)); else RUNREP(REP_LRU, lru::ph_lru<true>(a.p, lds, vcu, G)); }
    BAR(pb + 1);
    if (IN(pb + 2)) { if constexpr (l == 0) { RUNREP(REP_HG, hg::ph_hgrn<false>(a.p, lds, vcu, G)); RUNREP(REP_DA, att::ph_diffattn(a.p, lds, vcu, G)); }
                      else { RUNREP(REP_LRU, lru::ph_lru<false>(a.p, lds, vcu, G)); RUNREP(REP_SB, att::ph_sbattn(a.p, lds, vcu, G)); } }
    BAR(pb + 2);
    if (IN(pb + 3)) {
        pg8::Gemm g{(const bf16_t*)(ws + WS_H), (const bf16_t*)(ws + (l == 0 ? WS_WOUTE : WS_WOUTO)), 1024, 0};
        pg8::StaticOrder S; S.init(M_, 1024, G, bx);
        pg8::EpiAct E{(bf16_t*)(ws + WS_P), 1024, 0ull, 1.f};
        RUNREP(REP_DENSE, pg8::gemm_phase<pg8::EpiAct, pg8::StaticOrder, true, false>(lds, g, S, E));
    }
    BAR(pb + 3);
    if (IN(pb + 4)) ph_lnr(a.p, l, lds);
    BAR(pb + 4);
    if (IN(pb + 5)) {
        moe_table(a.p, l, lds);
        pg8::Gemm g{(const bf16_t*)(ws + WS_H), (const bf16_t*)(ws + WS_GU) + (size_t)l * 16 * 1024 * 1024, 1024, (size_t)1024 * 1024};
        pg8::MoeOrder S{(const LAS int*)(lds + LDS_CTL), (const int*)(ws + WS_LIST), G, vcu, 4};
        pg8::EpiGU E{(bf16_t*)(ws + WS_P)};
        RUNREP(REP_MOE, pg8::gemm_phase<pg8::EpiGU, pg8::MoeOrder, true, true>(lds, g, S, E));
    }
    BAR(pb + 5);
    if (IN(pb + 6)) {
        moe_table(a.p, l, lds);
        pg8::Gemm g{(const bf16_t*)(ws + WS_P), (const bf16_t*)(ws + WS_DN) + (size_t)l * 16 * 1024 * 512, 512, (size_t)1024 * 512};
        pg8::MoeOrder S{(const LAS int*)(lds + LDS_CTL), (const int*)(ws + WS_LIST), G, vcu, 4};
        pg8::EpiAct E{(bf16_t*)(ws + WS_YS), 1024, 0ull, 1.f};
        RUNREP(REP_MOE, pg8::gemm_phase<pg8::EpiAct, pg8::MoeOrder, true, false>(lds, g, S, E));
    }
    BAR(pb + 6);
    if (IN(pb + 7)) { if (OPT_MOE) ph_ln2<false>(a.p, l, lds); else ph_ln2<true>(a.p, l, lds); }
    BAR(pb + 7);
#undef IN
#undef BAR
}
__global__ void __launch_bounds__(512, 2) fwd(Args a) {
    extern __shared__ __attribute__((aligned(16))) unsigned char lds_raw[];
    LAS unsigned char* lds = (LAS unsigned char*)lds_raw;
    const int lo = a.ph_lo, hi = a.ph_hi;
    const int G = gridDim.x, bx = blockIdx.x; const int vcu = (G % 8 == 0) ? (bx % 8) * (G / 8) + bx / 8 : bx;
    if (threadIdx.x < 4) ((LAS unsigned*)(lds + LDS_CTL + 256))[threadIdx.x] = 0u;
    __syncthreads();
    const XcdBarrier bar = xcd_barrier_post((unsigned*)(a.p.ws + WS_CTL) + CW_BAR, (volatile LAS unsigned*)(lds + LDS_CTL + 256));
    if (lo <= 0 && 0 < hi) RUNREP(REP_PRO, ph_prologue(a.p, lds));
    if (lo <= 0 && 1 < hi) xcd_barrier(bar);
    if (lo <= 1 && 1 < hi) RUNREP(REP_PRO, ph_modulate(a.p));
    if (lo <= 1 && 2 < hi) xcd_barrier(bar);
    layer_phases<0>(a, lds, lo, hi, G, bx, vcu, bar);
    layer_phases<1>(a, lds, lo, hi, G, bx, vcu, bar);
}

extern "C" void kernel_launch(void* const* d_in, const int* in_sizes, int n_in, void* d_out, int out_size, void* d_ws, size_t ws_size, hipStream_t stream) {
    static int grid = 0;
    if (grid == 0) {
        if (n_in != 26 || out_size != M_ * D_ || ws_size < WS_END) { fprintf(stderr, "kernel_launch: unexpected shapes (n_in %d out %d ws %zu)\n", n_in, out_size, ws_size); grid = -1; return; }
        int dev = 0, cus = 0;
        hipGetDevice(&dev); hipDeviceGetAttribute(&cus, hipDeviceAttributeMultiprocessorCount, dev);
        hipFuncSetAttribute((const void*)fwd, hipFuncAttributeMaxDynamicSharedMemorySize, LDS_BYTES);
        grid = cus > 0 ? cus : 256;
    }
    if (grid < 0) return;
    hipMemsetAsync((char*)d_ws + WS_CTL, 0, CTL_BYTES, stream);
    Args a{};
    for (int i = 0; i < 26; ++i) a.p.in[i] = (const float*)d_in[i];
    a.p.out = (float*)d_out; a.p.ws = (unsigned char*)d_ws;
    unsigned char* ws = (unsigned char*)d_ws;
    auto run = [&](int k) { a.ph_lo = k; a.ph_hi = k + 1; hipLaunchKernelGGL(fwd, dim3(grid), dim3(512), LDS_BYTES, stream, a); };
    bf16_t* H = (bf16_t*)(ws + WS_H); bf16_t* PR = (bf16_t*)(ws + WS_P); bf16_t* YS = (bf16_t*)(ws + WS_YS);
    if (SINGLE_LAUNCH) { a.ph_lo = 0; a.ph_hi = 18; hipLaunchKernelGGL(fwd, dim3(grid), dim3(512), LDS_BYTES, stream, a); return; }
    run(0); run(1);
    for (int l = 0; l < 2; ++l) {
        const int pb = 2 + 8 * l;
        if (l == 0) {
            const unsigned long long modes = 0x11ull | (0x22ull << 24) | (0x22ull << 48);
            if (OPT_GEMM) run(pb + 0); else hipLaunchKernelGGL(ngemm, dim3(P0 / 64, M_ / 64), dim3(256), 0, stream, H, (const bf16_t*)(ws + WS_WINE), PR, P0, 1024, modes, QSC);
            if (OPT_HG) run(pb + 1);
            if (OPT_DA) run(pb + 2); else hipLaunchKernelGGL(nda, dim3(M_ * 4 / 4), dim3(256), 0, stream, PR, H, (const float*)d_in[8], (const float*)d_in[9]);
            if (!OPT_HG) hipLaunchKernelGGL(nhg, dim3(32), dim3(512), 0, stream, PR, H, (const float*)d_in[10], (const float*)d_in[11]);
            if (OPT_GEMM) run(pb + 3); else hipLaunchKernelGGL(ngemm, dim3(1024 / 64, M_ / 64), dim3(256), 0, stream, H, (const bf16_t*)(ws + WS_WOUTE), PR, 1024, 1024, 0ull, 1.f);
        } else {
            const unsigned long long modes = (0x33ull << 8) | (0x11ull << 16);
            if (OPT_GEMM) run(pb + 0); else hipLaunchKernelGGL(ngemm, dim3(P1 / 64, M_ / 64), dim3(256), 0, stream, H, (const bf16_t*)(ws + WS_WINO), PR, P1, 1024, modes, QSC);
            if (OPT_LRU) run(pb + 1); else hipLaunchKernelGGL(nlru, dim3(64), dim3(64), 0, stream, PR, H, (const float*)d_in[14], (const float*)d_in[15], (const float*)d_in[16], (const float*)d_in[17], (const float*)d_in[18], (const float*)d_in[19], (const float*)d_in[20]);
            if (OPT_SB) run(pb + 2); else hipLaunchKernelGGL(nsb, dim3(M_ * 8 / 4), dim3(256), 0, stream, PR, H);
            if (OPT_GEMM) run(pb + 3); else hipLaunchKernelGGL(ngemm, dim3(1024 / 64, M_ / 64), dim3(256), 0, stream, H, (const bf16_t*)(ws + WS_WOUTO), PR, 1024, 1024, 0ull, 1.f);
        }
        run(pb + 4);
        if (OPT_MOE) { run(pb + 5); run(pb + 6); } else hipLaunchKernelGGL(nmoe, dim3(M_), dim3(256), 0, stream, H, (const TokInfo*)(ws + WS_TOK), (const bf16_t*)(ws + WS_GU) + (size_t)l * 16 * 1024 * 1024, (const bf16_t*)(ws + WS_DN) + (size_t)l * 16 * 1024 * 512, YS);
        run(pb + 7);
    }
}
```

```cpp
#include <hip/hip_runtime.h>
#include <cstdio>
#include <cstdint>

#define GAS __attribute__((address_space(1)))
#define LAS __attribute__((address_space(3)))
typedef unsigned short bf16_t;
typedef short bf16x8 __attribute__((ext_vector_type(8)));
typedef float f32x4 __attribute__((ext_vector_type(4)));
typedef float f32x16 __attribute__((ext_vector_type(16)));
typedef unsigned u32x4 __attribute__((ext_vector_type(4)));
typedef unsigned u32x2 __attribute__((ext_vector_type(2)));

constexpr int B_ = 8, T_ = 4096, D_ = 1024, M_ = B_ * T_;
constexpr int P0 = 3584, P1 = 2560;
constexpr int NE = 16;
constexpr float LOG2E = 1.4426950408889634f, LN2F = 0.6931471805599453f;
constexpr float ALPHA = 1.4142135623730951f;
constexpr float QSC = 0.125f * 1.4426950408889634f;
constexpr float LN_EPS = 1e-5f, RMS_EPS = 1e-6f;
constexpr float LAM_INIT0 = 0.2f;

constexpr size_t MiB = 1u << 20;
constexpr size_t WS_CTL = 0, CTL_BYTES = 1 * MiB;
constexpr size_t WS_MOD = 1 * MiB;
constexpr size_t WS_TOK = 2 * MiB;
constexpr size_t WS_LIST = 3 * MiB;
constexpr size_t WS_LRU = 5 * MiB;
constexpr size_t WS_HGD = 6 * MiB;
constexpr size_t WS_HGS = 8 * MiB;
constexpr size_t WS_WINE = 24 * MiB, WS_WOUTE = 31 * MiB, WS_WINO = 33 * MiB, WS_WOUTO = 38 * MiB;
constexpr size_t WS_GU = 40 * MiB;
constexpr size_t WS_DN = 104 * MiB;
constexpr size_t WS_H = 136 * MiB;
constexpr size_t WS_P = 200 * MiB;
constexpr size_t WS_YS = WS_P + 68 * MiB;
constexpr size_t WS_XS = 424 * MiB;
constexpr size_t WS_END = 492 * MiB;
constexpr int CW_GCNT = 64;
constexpr int CW_BAR = 4096;
constexpr int CW_DAQ = 96;
constexpr int CW_KMAX = 128;

#ifndef OPT_GEMM
#define OPT_GEMM 1
#endif
#ifndef OPT_SB
#define OPT_SB 1
#endif
#ifndef OPT_HG
#define OPT_HG 1
#endif
#ifndef SINGLE_LAUNCH
#define SINGLE_LAUNCH 1
#endif
#ifndef OPT_LRU
#define OPT_LRU 1
#endif
#ifndef OPT_DA
#define OPT_DA 1
#endif
#ifndef OPT_MOE
#define OPT_MOE 1
#endif
struct TokInfo { int ep1, ep2; float w1, w2; };

__device__ __forceinline__ float bf2f(bf16_t v) { return __uint_as_float((unsigned)v << 16); }
typedef float f32x2_t __attribute__((ext_vector_type(2))); typedef __bf16 bf16x2_t __attribute__((ext_vector_type(2)));
__device__ __forceinline__ unsigned cvt_pk_bf16(float lo, float hi) { f32x2_t v = {lo, hi}; bf16x2_t b = __builtin_convertvector(v, bf16x2_t); return __builtin_bit_cast(unsigned, b); }
__device__ __forceinline__ bf16_t f2bf(float f) { return (bf16_t)(cvt_pk_bf16(f, 0.f) & 0xffffu); }
__device__ __forceinline__ float fexp2(float x) { return __builtin_amdgcn_exp2f(x); }
__device__ __forceinline__ float fexp(float x) { return __builtin_amdgcn_exp2f(x * LOG2E); }
__device__ __forceinline__ float frcp(float x) { return __builtin_amdgcn_rcpf(x); }
__device__ __forceinline__ float sigmoidf_(float x) { return frcp(1.f + fexp(-x)); }
__device__ __forceinline__ float siluf_(float x) { return x * sigmoidf_(x); }
__device__ __forceinline__ float gelu_t(float x) { const float u = 0.7978845608028654f * (x + 0.044715f * x * x * x); const float t = fexp(2.f * u); return 0.5f * x * (2.f - 2.f * frcp(t + 1.f)); }
__device__ __forceinline__ float softplusf_(float x) { return fmaxf(x, 0.f) + log1pf(expf(-fabsf(x))); }
__device__ __forceinline__ float wave_sum(float v) {
#pragma unroll
    for (int o = 1; o < 64; o <<= 1) v += __shfl_xor(v, o);
    return v;
}
__device__ __forceinline__ float wave_max(float v) {
#pragma unroll
    for (int o = 1; o < 64; o <<= 1) v = fmaxf(v, __shfl_xor(v, o));
    return v;
}
__device__ __forceinline__ float act_mode(float v, int mode, float qs) {
    if (mode == 1) return v * qs;
    if (mode == 2) return siluf_(v);
    if (mode == 3) return gelu_t(v);
    return v;
}

struct Ptrs {
    const float* in[26]; float* out; unsigned char* ws;
};

__device__ __forceinline__ void transpose_item(const float* W, int K, int N, bf16_t* WT, int row_delta, LAS float* scr, int item, int lane) {
    const int nblk = N / 32, kb = item / nblk, nb = item % nblk, k0 = 64 * kb, n0 = 32 * nb;
#pragma unroll 8
    for (int i = 0; i < 32; ++i) { const int kk = 2 * i + (lane >> 5); scr[kk * 33 + (lane & 31)] = W[(size_t)(k0 + kk) * N + n0 + (lane & 31)]; }
    asm volatile("s_waitcnt lgkmcnt(0)" ::: "memory");
    const int c = lane & 7;
#pragma unroll
    for (int j = 0; j < 4; ++j) { const int n = (lane >> 3) + 8 * j; const LAS float* s = scr + (8 * c) * 33 + n;
        u32x4 o; o.x = cvt_pk_bf16(s[0 * 33], s[1 * 33]); o.y = cvt_pk_bf16(s[2 * 33], s[3 * 33]); o.z = cvt_pk_bf16(s[4 * 33], s[5 * 33]); o.w = cvt_pk_bf16(s[6 * 33], s[7 * 33]);
        *(u32x4*)(WT + (size_t)(n0 + n + row_delta) * K + k0 + 8 * c) = o; }
    asm volatile("s_waitcnt lgkmcnt(0)" ::: "memory");
}

__device__ __forceinline__ void ph_prologue(const Ptrs& P, LAS unsigned char* lds) {
    const int tid = threadIdx.x, lane = tid & 63, wid = tid >> 6, G = gridDim.x;
    unsigned char* ws = P.ws;
    {
        LAS float* cond = (LAS float*)lds;
        LAS float* part = (LAS float*)(lds + 32768);
        bool have = false;
        for (int it = blockIdx.x; it < 192; it += G) {
            if (!have) { const float* c = P.in[1]; for (int i = tid; i < 8192; i += 512) cond[i] = siluf_(c[i]); have = true; __syncthreads(); }
            const int l = it / 96, cg = it % 96, col = cg * 64 + lane;
            const float* w = P.in[2] + (size_t)l * 1024 * 6144 + col;
            float acc[8];
#pragma unroll
            for (int b = 0; b < 8; ++b) acc[b] = 0.f;
            for (int k = wid * 128; k < wid * 128 + 128; ++k) { const float wv = w[(size_t)k * 6144];
#pragma unroll
                for (int b = 0; b < 8; ++b) acc[b] += cond[b * 1024 + k] * wv; }
#pragma unroll
            for (int b = 0; b < 8; ++b) part[(wid * 8 + b) * 64 + lane] = acc[b];
            __syncthreads();
            { const int b = tid >> 6; float s = 0.f;
#pragma unroll
              for (int w8 = 0; w8 < 8; ++w8) s += part[(w8 * 8 + b) * 64 + lane];
              ((float*)(ws + WS_MOD))[(size_t)(l * 8 + b) * 6144 + col] = s + P.in[3][l * 6144 + col]; }
            __syncthreads();
        }
        __syncthreads();
    }
    LAS float* scr = (LAS float*)(lds + wid * 16384);
    const int gw = blockIdx.x * 8 + wid, NGW = G * 8;
    constexpr int I0 = 16 * 112, I1 = 512, I2 = 16 * 80, I3 = 512, IM = 256, NIT = I0 + I1 + I2 + I3 + 3 * 32 * IM;
    for (int it = gw; it < NIT; it += NGW) {
        int r = it;
        if (r < I0) { transpose_item(P.in[6], 1024, 3584, (bf16_t*)(ws + WS_WINE), 0, scr, r, lane); continue; } r -= I0;
        if (r < I1) { transpose_item(P.in[7], 1024, 1024, (bf16_t*)(ws + WS_WOUTE), 0, scr, r, lane); continue; } r -= I1;
        if (r < I2) { transpose_item(P.in[12], 1024, 2560, (bf16_t*)(ws + WS_WINO), 0, scr, r, lane); continue; } r -= I2;
        if (r < I3) { transpose_item(P.in[13], 1024, 1024, (bf16_t*)(ws + WS_WOUTO), 0, scr, r, lane); continue; } r -= I3;
        const int kind = r / (32 * IM); r -= kind * 32 * IM; const int le = r / IM, item = r % IM;
        if (kind < 2) {
            const int nb = item % 16, n0 = nb * 32; const int delta = (256 * (n0 >> 7) + 128 * kind + (n0 & 127)) - n0;
            transpose_item((kind == 0 ? P.in[23] : P.in[24]) + (size_t)le * 1024 * 512, 1024, 512, (bf16_t*)(ws + WS_GU) + (size_t)le * 1024 * 1024, delta, scr, item, lane);
        } else {
            transpose_item(P.in[25] + (size_t)le * 512 * 1024, 512, 1024, (bf16_t*)(ws + WS_DN) + (size_t)le * 1024 * 512, 0, scr, item, lane);
        }
    }
}

__device__ __forceinline__ void ph_modulate(const Ptrs& P) {
    const int tid = threadIdx.x, lane = tid & 63, wid = tid >> 6;
    const int gw = blockIdx.x * 8 + wid, NGW = gridDim.x * 8;
    const float* mod = (const float*)(P.ws + WS_MOD);
    bf16_t* H = (bf16_t*)(P.ws + WS_H);
    for (int m = gw; m < M_; m += NGW) {
        const int b = m >> 12; const float* mb = mod + (size_t)b * 6144;
        const float* xr = P.in[0] + (size_t)m * D_;
#pragma unroll
        for (int j = 0; j < 4; ++j) { const int c = 4 * lane + 256 * j;
            const f32x4 x = *(const f32x4*)(xr + c), sh = *(const f32x4*)(mb + c), sc = *(const f32x4*)(mb + 1024 + c);
            const f32x4 h = x * (1.f + sc) + sh; u32x2 o; o.x = cvt_pk_bf16(h[0], h[1]); o.y = cvt_pk_bf16(h[2], h[3]);
            *(u32x2*)(H + (size_t)m * D_ + c) = o; }
    }
}

__device__ __forceinline__ f32x4 bf4(u32x2 v) { f32x4 y; y[0] = __uint_as_float(v.x << 16); y[1] = __uint_as_float(v.x & 0xffff0000u); y[2] = __uint_as_float(v.y << 16); y[3] = __uint_as_float(v.y & 0xffff0000u); return y; }
__device__ __forceinline__ float swapother(float v, int hi) { auto rr = __builtin_amdgcn_permlane32_swap(__float_as_uint(v), __float_as_uint(v), false, false); return hi ? __uint_as_float(rr[0]) : __uint_as_float(rr[1]); }
__device__ __forceinline__ float rdlane(float v, int l) { return __int_as_float(__builtin_amdgcn_readlane(__float_as_int(v), l)); }
__device__ __forceinline__ void ph_lnr(const Ptrs& P, int l, LAS unsigned char* lds) {
    const int tid = threadIdx.x, lane = tid & 63, wid = tid >> 6, G = gridDim.x;
    unsigned char* ws = P.ws;
    LAS f32x4* RW = (LAS f32x4*)lds;
    LAS int* se = (LAS int*)(lds + 65536);
    LAS int* hist = (LAS int*)(lds + 65536 + 1024);
    LAS int* base = (LAS int*)(lds + 65536 + 1024 + 64);
    const float* rw = P.in[21];
    for (int i = tid; i < 4096; i += 512) { const int idx = i >> 6, ln = i & 63, q = idx & 3, ji = idx >> 2, j = ji >> 2, ii = ji & 3; const int c = 4 * ln + 256 * j + ii;
        RW[i] = *(const f32x4*)(rw + (size_t)c * 16 + 4 * q); }
    if (tid < 16) hist[tid] = 0;
    __syncthreads();
    const float* mod = (const float*)(ws + WS_MOD) + (size_t)l * 8 * 6144;
    const float* xsrc = P.in[0]; bf16_t* XS = (bf16_t*)(ws + WS_XS);
    const bf16_t* Y = (const bf16_t*)(ws + WS_P);
    bf16_t* H = (bf16_t*)(ws + WS_H);
    TokInfo* tok = (TokInfo*)(ws + WS_TOK);
    int* list = (int*)(ws + WS_LIST);
    unsigned* gcnt = (unsigned*)(ws + WS_CTL) + CW_GCNT + l * 16;
    const float* lng = P.in[4] + (size_t)(l * 2 + 0) * 1024, * lnb = P.in[5] + (size_t)(l * 2 + 0) * 1024;
    float rb[16];
#pragma unroll
    for (int e = 0; e < 16; ++e) rb[e] = P.in[22][e];
    const int hi = lane >> 5;
    for (int ch = blockIdx.x; ch < M_ / 128; ch += G) {
        const int b = (ch * 128) >> 12; const float* mb = mod + (size_t)b * 6144;
        f32x4 vg1[4], vg[4], vb[4], vsh[4], vsc[4];
#pragma unroll
        for (int j = 0; j < 4; ++j) { const int c = 4 * lane + 256 * j; vg1[j] = 1.f + *(const f32x4*)(mb + 2048 + c); vg[j] = *(const f32x4*)(lng + c); vb[j] = *(const f32x4*)(lnb + c);
            vsh[j] = *(const f32x4*)(mb + 3072 + c); vsc[j] = 1.f + *(const f32x4*)(mb + 4096 + c); }
        const int m0 = ch * 128 + wid * 16;
        f32x4 xn[4]; u32x2 yn[4];
#pragma unroll
        for (int j = 0; j < 4; ++j) { const int c = 4 * lane + 256 * j; xn[j] = (l == 0) ? *(const f32x4*)(xsrc + (size_t)m0 * D_ + c) : bf4(*(const u32x2*)(XS + (size_t)m0 * D_ + c)); yn[j] = *(const u32x2*)(Y + (size_t)m0 * D_ + c); }
        for (int i = 0; i < 16; ++i) {
            const int rl = wid * 16 + i, m = m0 + i;
            f32x4 v[4]; float s = 0.f;
#pragma unroll
            for (int j = 0; j < 4; ++j) { v[j] = ALPHA * xn[j] + vg1[j] * bf4(yn[j]); s += (v[j][0] + v[j][1]) + (v[j][2] + v[j][3]); }
            if (i < 15) {
#pragma unroll
                for (int j = 0; j < 4; ++j) { const int c = 4 * lane + 256 * j; xn[j] = (l == 0) ? *(const f32x4*)(xsrc + (size_t)(m + 1) * D_ + c) : bf4(*(const u32x2*)(XS + (size_t)(m + 1) * D_ + c)); yn[j] = *(const u32x2*)(Y + (size_t)(m + 1) * D_ + c); } }
            const float mean = wave_sum(s) * (1.f / D_); float s2 = 0.f;
#pragma unroll
            for (int j = 0; j < 4; ++j) { v[j] = v[j] - mean; s2 += (v[j][0] * v[j][0] + v[j][1] * v[j][1]) + (v[j][2] * v[j][2] + v[j][3] * v[j][3]); }
            const float rstd = 1.f / sqrtf(wave_sum(s2) * (1.f / D_) + LN_EPS);
            float acc[16];
#pragma unroll
            for (int e = 0; e < 16; ++e) acc[e] = 0.f;
#pragma unroll
            for (int j = 0; j < 4; ++j) { const int c = 4 * lane + 256 * j;
                const f32x4 x1 = v[j] * rstd * vg[j] + vb[j];
                { u32x2 ox; ox.x = cvt_pk_bf16(x1[0], x1[1]); ox.y = cvt_pk_bf16(x1[2], x1[3]); *(u32x2*)(XS + (size_t)m * D_ + c) = ox; }
                const f32x4 h = x1 * vsc[j] + vsh[j]; u32x2 o; o.x = cvt_pk_bf16(h[0], h[1]); o.y = cvt_pk_bf16(h[2], h[3]);
                *(u32x2*)(H + (size_t)m * D_ + c) = o;
#pragma unroll
                for (int ii = 0; ii < 4; ++ii)
#pragma unroll
                    for (int q = 0; q < 4; ++q) { const f32x4 w = RW[((j * 4 + ii) * 4 + q) * 64 + lane];
                        acc[4 * q + 0] += h[ii] * w[0]; acc[4 * q + 1] += h[ii] * w[1]; acc[4 * q + 2] += h[ii] * w[2]; acc[4 * q + 3] += h[ii] * w[3]; }
                asm volatile("" ::: "memory");
            }
            float r8[8], r4[4], r2[2], r1;
#pragma unroll
            for (int k = 0; k < 8; ++k) { const float send = hi ? acc[k] : acc[8 + k]; const float keep = hi ? acc[8 + k] : acc[k]; r8[k] = keep + swapother(send, hi); }
            { const int b4 = (lane >> 4) & 1;
#pragma unroll
              for (int k = 0; k < 4; ++k) { const float send = b4 ? r8[k] : r8[4 + k]; const float keep = b4 ? r8[4 + k] : r8[k]; r4[k] = keep + __shfl_xor(send, 16); } }
            { const int b3 = (lane >> 3) & 1;
#pragma unroll
              for (int k = 0; k < 2; ++k) { const float send = b3 ? r4[k] : r4[2 + k]; const float keep = b3 ? r4[2 + k] : r4[k]; r2[k] = keep + __shfl_xor(send, 8); } }
            { const int b2 = (lane >> 2) & 1; const float send = b2 ? r2[0] : r2[1]; const float keep = b2 ? r2[1] : r2[0]; r1 = keep + __shfl_xor(send, 4); }
            r1 += __shfl_xor(r1, 2); r1 += __shfl_xor(r1, 1);
            float p[16]; float mx = -1e30f;
#pragma unroll
            for (int e = 0; e < 16; ++e) { p[e] = rdlane(r1, 4 * e) + rb[e]; mx = fmaxf(mx, p[e]); }
            float ps = 0.f;
#pragma unroll
            for (int e = 0; e < 16; ++e) { p[e] = expf(p[e] - mx); ps += p[e]; }
            const float inv = 1.f / ps;
#pragma unroll
            for (int e = 0; e < 16; ++e) p[e] *= inv;
            int gs = 0; float best = -1.f, q0 = 0.f, q1 = 0.f, q2 = 0.f, q3 = 0.f;
#pragma unroll
            for (int g = 0; g < 4; ++g) { const float a = p[4 * g], b2 = p[4 * g + 1], c2 = p[4 * g + 2], d2 = p[4 * g + 3];
                const float t2 = fmaxf(fmaxf(fmaxf(a + b2, a + c2), fmaxf(a + d2, b2 + c2)), fmaxf(b2 + d2, c2 + d2));
                const bool better = t2 > best;
                best = better ? t2 : best; gs = better ? g : gs; q0 = better ? a : q0; q1 = better ? b2 : q1; q2 = better ? c2 : q2; q3 = better ? d2 : q3; }
            int i1 = 0; float t1 = q0;
            if (q1 > t1) { t1 = q1; i1 = 1; } if (q2 > t1) { t1 = q2; i1 = 2; } if (q3 > t1) { t1 = q3; i1 = 3; }
            int i2 = -1; float t2v = -1.f;
            if (i1 != 0 && q0 > t2v) { t2v = q0; i2 = 0; } if (i1 != 1 && q1 > t2v) { t2v = q1; i2 = 1; }
            if (i1 != 2 && q2 > t2v) { t2v = q2; i2 = 2; } if (i1 != 3 && q3 > t2v) { t2v = q3; i2 = 3; }
            const float wsum = t1 + t2v;
            if (lane == 0) { se[rl * 2 + 0] = gs * 4 + i1; se[rl * 2 + 1] = gs * 4 + i2; tok[m].w1 = t1 / wsum; tok[m].w2 = t2v / wsum; }
        }
        __syncthreads();
        int e = 0, rank = 0;
        if (tid < 256) { e = se[tid]; rank = atomicAdd((int*)&hist[e], 1); }
        __syncthreads();
        if (tid < 16) { base[tid] = (int)__hip_atomic_fetch_add(gcnt + tid, (unsigned)hist[tid], __ATOMIC_RELAXED, __HIP_MEMORY_SCOPE_AGENT); }
        __syncthreads();
        if (tid < 256) { const int pos = base[e] + rank, m = ch * 128 + (tid >> 1); list[(size_t)e * M_ + pos] = m;
            if (tid & 1) tok[m].ep2 = (e << 20) | pos; else tok[m].ep1 = (e << 20) | pos; }
        if (tid < 16) hist[tid] = 0;
        __syncthreads();
    }
}

template <bool NAIVE_Y>
__device__ __forceinline__ void ph_ln2(const Ptrs& P, int l, LAS unsigned char* lds) {
    const int tid = threadIdx.x, lane = tid & 63, wid = tid >> 6;
    unsigned char* ws = P.ws;
    LAS int* segrow = (LAS int*)lds;
    if (tid == 0) { const unsigned* gcnt = (const unsigned*)(ws + WS_CTL) + CW_GCNT + l * 16; int acc = 0;
        for (int e = 0; e < 16; ++e) { segrow[e] = acc; const unsigned c = __hip_atomic_load(gcnt + e, __ATOMIC_RELAXED, __HIP_MEMORY_SCOPE_AGENT); acc += (int)((c + 255u) >> 8) * 256; } }
    __syncthreads();
    const float* mod = (const float*)(ws + WS_MOD);
    const bf16_t* YS = (const bf16_t*)(ws + WS_YS);
    const TokInfo* tok = (const TokInfo*)(ws + WS_TOK);
    bf16_t* H = (bf16_t*)(ws + WS_H); bf16_t* XS = (bf16_t*)(ws + WS_XS);
    const float* lng = P.in[4] + (size_t)(l * 2 + 1) * 1024, * lnb = P.in[5] + (size_t)(l * 2 + 1) * 1024;
    const int gw = blockIdx.x * 8 + wid, NGW = gridDim.x * 8;
    for (int cc = gw; cc < M_ / 16; cc += NGW) {
        const int m0 = cc * 16, b = m0 >> 12; const float* mb = mod + (size_t)(l * 8 + b) * 6144; const float* mb1 = mod + (size_t)(8 + b) * 6144;
        f32x4 vg2[4], vg[4], vb[4], vsh[4], vsc[4];
#pragma unroll
        for (int j = 0; j < 4; ++j) { const int c = 4 * lane + 256 * j; vg2[j] = 1.f + *(const f32x4*)(mb + 5120 + c); vg[j] = *(const f32x4*)(lng + c); vb[j] = *(const f32x4*)(lnb + c);
            if (l == 0) { vsh[j] = *(const f32x4*)(mb1 + c); vsc[j] = 1.f + *(const f32x4*)(mb1 + 1024 + c); } }
        int r1l = 0, r2l = 0; float w1l = 0.f, w2l = 0.f;
        if (lane < 16) { const TokInfo ti = tok[m0 + lane]; r1l = NAIVE_Y ? (m0 + lane) : (segrow[ti.ep1 >> 20] + (ti.ep1 & 0xfffff)); r2l = NAIVE_Y ? (m0 + lane) : (segrow[ti.ep2 >> 20] + (ti.ep2 & 0xfffff)); w1l = ti.w1; w2l = ti.w2; }
        f32x4 xn[4]; u32x2 yan[4], ybn[4];
        { const size_t r1 = (size_t)__builtin_amdgcn_readlane(r1l, 0), r2 = (size_t)__builtin_amdgcn_readlane(r2l, 0);
#pragma unroll
          for (int j = 0; j < 4; ++j) { const int c = 4 * lane + 256 * j; xn[j] = bf4(*(const u32x2*)(XS + (size_t)m0 * D_ + c)); yan[j] = *(const u32x2*)(YS + r1 * D_ + c); ybn[j] = *(const u32x2*)(YS + r2 * D_ + c); } }
#pragma unroll 1
        for (int i = 0; i < 16; ++i) {
            const int m = m0 + i; const float w1 = rdlane(w1l, i), w2 = rdlane(w2l, i);
            f32x4 v[4]; float s = 0.f;
#pragma unroll
            for (int j = 0; j < 4; ++j) { f32x4 y = bf4(yan[j]); if (!NAIVE_Y) y = w1 * y + w2 * bf4(ybn[j]); v[j] = ALPHA * xn[j] + vg2[j] * y; s += (v[j][0] + v[j][1]) + (v[j][2] + v[j][3]); }
            if (i < 15) { const size_t r1 = (size_t)__builtin_amdgcn_readlane(r1l, i + 1), r2 = (size_t)__builtin_amdgcn_readlane(r2l, i + 1);
#pragma unroll
                for (int j = 0; j < 4; ++j) { const int c = 4 * lane + 256 * j; xn[j] = bf4(*(const u32x2*)(XS + (size_t)(m + 1) * D_ + c)); yan[j] = *(const u32x2*)(YS + r1 * D_ + c); ybn[j] = *(const u32x2*)(YS + r2 * D_ + c); } }
            const float mean = wave_sum(s) * (1.f / D_); float s2 = 0.f;
#pragma unroll
            for (int j = 0; j < 4; ++j) { v[j] = v[j] - mean; s2 += (v[j][0] * v[j][0] + v[j][1] * v[j][1]) + (v[j][2] * v[j][2] + v[j][3] * v[j][3]); }
            const float rstd = 1.f / sqrtf(wave_sum(s2) * (1.f / D_) + LN_EPS);
#pragma unroll
            for (int j = 0; j < 4; ++j) { const int c = 4 * lane + 256 * j;
                const f32x4 x2 = v[j] * rstd * vg[j] + vb[j];
                if (l == 1) *(f32x4*)(P.out + (size_t)m * D_ + c) = x2; else { u32x2 ox; ox.x = cvt_pk_bf16(x2[0], x2[1]); ox.y = cvt_pk_bf16(x2[2], x2[3]); *(u32x2*)(XS + (size_t)m * D_ + c) = ox; }
                if (l == 0) { const f32x4 h = x2 * vsc[j] + vsh[j]; u32x2 o; o.x = cvt_pk_bf16(h[0], h[1]); o.y = cvt_pk_bf16(h[2], h[3]); *(u32x2*)(H + (size_t)m * D_ + c) = o; }
            }
        }
    }
}

__global__ void __launch_bounds__(256) ngemm(const bf16_t* A, const bf16_t* Bt, bf16_t* C, int N, int K, unsigned long long modes, float qs) {
    __shared__ float As[32][65], Bs[32][65];
    const int tid = threadIdx.x, tx = tid & 15, ty = tid >> 4;
    const int m0 = blockIdx.y * 64, n0 = blockIdx.x * 64;
    float acc[4][4] = {};
    const int lr = tid >> 2, lk = (tid & 3) * 8;
    for (int k0 = 0; k0 < K; k0 += 32) {
        const bf16x8 av = *(const bf16x8*)(A + (size_t)(m0 + lr) * K + k0 + lk), bv = *(const bf16x8*)(Bt + (size_t)(n0 + lr) * K + k0 + lk);
#pragma unroll
        for (int i = 0; i < 8; ++i) { As[lk + i][lr] = bf2f((bf16_t)av[i]); Bs[lk + i][lr] = bf2f((bf16_t)bv[i]); }
        __syncthreads();
#pragma unroll 8
        for (int kk = 0; kk < 32; ++kk) { float a[4], b[4];
#pragma unroll
            for (int i = 0; i < 4; ++i) { a[i] = As[kk][ty * 4 + i]; b[i] = Bs[kk][tx * 4 + i]; }
#pragma unroll
            for (int i = 0; i < 4; ++i)
#pragma unroll
                for (int j = 0; j < 4; ++j) acc[i][j] += a[i] * b[j]; }
        __syncthreads();
    }
    const int mode = (int)((modes >> (4 * (n0 >> 8))) & 15ull);
#pragma unroll
    for (int i = 0; i < 4; ++i)
#pragma unroll
        for (int j = 0; j < 4; ++j) C[(size_t)(m0 + ty * 4 + i) * N + n0 + tx * 4 + j] = f2bf(act_mode(acc[i][j], mode, qs));
}

__global__ void __launch_bounds__(256) nda(const bf16_t* proj, bf16_t* mix, const float* dlam, const float* gain) {
    const int lane = threadIdx.x & 63, rid = blockIdx.x * 4 + (threadIdx.x >> 6);
    const int h = rid & 3, tokn = rid >> 2, b = tokn >> 12, i = tokn & 4095;
    float d01 = 0.f, d23 = 0.f;
    { const float a = dlam[lane] * dlam[64 + lane], c = dlam[128 + lane] * dlam[192 + lane]; d01 = wave_sum(a); d23 = wave_sum(c); }
    const float lam = expf(d01) - expf(d23) + LAM_INIT0;
    const float slope2 = exp2f(-2.f * (float)(h + 1)) * LOG2E;
    const bf16_t* qrow = proj + (size_t)tokn * P0 + h * 128;
    const size_t rb = (size_t)b * T_;
    float m0 = -1e30f, l0 = 0.f, m1 = -1e30f, l1 = 0.f;
    const int nch = (i >> 6) + 1;
    for (int jb = 0; jb < nch; ++jb) {
        const int j = jb * 64 + lane; const bool valid = j <= i;
        const bf16_t* krow = proj + (rb + (valid ? j : i)) * P0 + 512 + h * 128;
        float s0 = 0.f, s1 = 0.f;
        for (int d = 0; d < 64; ++d) { s0 += bf2f(qrow[d]) * bf2f(krow[d]); s1 += bf2f(qrow[64 + d]) * bf2f(krow[64 + d]); }
        const float bias = -slope2 * (float)(i - j); s0 += bias; s1 += bias;
        if (valid) { float mn = fmaxf(m0, s0); l0 = l0 * fexp2(m0 - mn) + fexp2(s0 - mn); m0 = mn; mn = fmaxf(m1, s1); l1 = l1 * fexp2(m1 - mn) + fexp2(s1 - mn); m1 = mn; }
    }
    const float M0 = wave_max(m0), M1 = wave_max(m1);
    const float L0 = wave_sum(l0 * fexp2(m0 - M0)), L1 = wave_sum(l1 * fexp2(m1 - M1));
    const float i0 = 1.f / L0, i1 = lam / L1;
    float o0 = 0.f, o1 = 0.f;
    for (int jb = 0; jb < nch; ++jb) {
        const int j = jb * 64 + lane; const bool valid = j <= i;
        const bf16_t* krow = proj + (rb + (valid ? j : i)) * P0 + 512 + h * 128;
        float s0 = 0.f, s1 = 0.f;
        for (int d = 0; d < 64; ++d) { s0 += bf2f(qrow[d]) * bf2f(krow[d]); s1 += bf2f(qrow[64 + d]) * bf2f(krow[64 + d]); }
        const float bias = -slope2 * (float)(i - j); s0 += bias; s1 += bias;
        const float a = valid ? (fexp2(s0 - M0) * i0 - fexp2(s1 - M1) * i1) : 0.f;
        const int jmax = min(64, i + 1 - jb * 64);
        for (int jj = 0; jj < jmax; ++jj) { const float aj = __shfl(a, jj); const bf16_t* vrow = proj + (rb + jb * 64 + jj) * P0 + 1024 + h * 128;
            o0 += aj * bf2f(vrow[lane]); o1 += aj * bf2f(vrow[64 + lane]); }
    }
    const float ssq = wave_sum(o0 * o0 + o1 * o1);
    const float rstd = 1.f / sqrtf(ssq * (1.f / 128.f) + RMS_EPS);
    bf16_t* orow = mix + (size_t)tokn * D_ + h * 128;
    orow[lane] = f2bf(o0 * rstd * gain[lane] * (1.f - LAM_INIT0)); orow[64 + lane] = f2bf(o1 * rstd * gain[64 + lane] * (1.f - LAM_INIT0));
}

__global__ void __launch_bounds__(512) nhg(const bf16_t* proj, bf16_t* mix, const float* gamma, const float* hgain) {
    __shared__ float qs[128], fs[128], ks[128], part[4][128], red[2];
    const int tid = threadIdx.x, dv = tid & 127, dq = tid >> 7, b = blockIdx.x >> 2, h = blockIdx.x & 3;
    float lb = 0.f;
    if (tid < 128) { const int c = h * 128 + tid; const float g0 = gamma[c], g1 = gamma[512 + c], g2 = gamma[1024 + c]; const float mx = fmaxf(g0, fmaxf(g1, g2));
        const float e0 = expf(g0 - mx), e1 = expf(g1 - mx), e2 = expf(g2 - mx); lb = e0 / (e0 + e1 + e2); }
    float S[32];
#pragma unroll
    for (int r = 0; r < 32; ++r) S[r] = 0.f;
    const float gn = hgain[dv];
    for (int t = 0; t < T_; ++t) {
        const bf16_t* row = proj + ((size_t)b * T_ + t) * P0;
        if (tid < 128) { const float q = bf2f(row[1536 + h * 128 + tid]), fl = bf2f(row[2048 + h * 128 + tid]);
            const float f = lb + (1.f - lb) * sigmoidf_(fl); qs[tid] = q; fs[tid] = f; ks[tid] = 1.f - f; }
        const float v = bf2f(row[2560 + h * 128 + dv]);
        __syncthreads();
        float p = 0.f;
#pragma unroll
        for (int r = 0; r < 32; ++r) { const int dk = dq * 32 + r; S[r] = fs[dk] * S[r] + ks[dk] * v; p += qs[dk] * S[r]; }
        part[dq][dv] = p;
        __syncthreads();
        float o = 0.f;
        if (tid < 128) { o = part[0][dv] + part[1][dv] + part[2][dv] + part[3][dv]; const float ss = wave_sum(o * o); if ((tid & 63) == 0) red[tid >> 6] = ss; }
        __syncthreads();
        if (tid < 128) { const float rstd = 1.f / sqrtf((red[0] + red[1]) * (1.f / 128.f) + RMS_EPS);
            mix[((size_t)b * T_ + t) * D_ + 512 + h * 128 + dv] = f2bf(o * rstd * gn * bf2f(row[3072 + h * 128 + dv])); }
    }
}

__global__ void __launch_bounds__(64) nlru(const bf16_t* proj, bf16_t* mix, const float* convw, const float* convb, const float* wa, const float* ba, const float* wx, const float* bx, const float* lam) {
    __shared__ float WA[64][64], WX[64][64], xcs[64];
    const int lane = threadIdx.x, b = blockIdx.x >> 3, g = blockIdx.x & 7, c = g * 64 + lane;
    for (int i = 0; i < 64; ++i) { WA[i][lane] = wa[(size_t)(g * 64 + i) * 64 + lane]; WX[i][lane] = wx[(size_t)(g * 64 + i) * 64 + lane]; }
    const float w0 = convw[c], w1 = convw[512 + c], w2 = convw[1024 + c], w3 = convw[1536 + c], cb = convb[c];
    const float bav = ba[c], bxv = bx[c], sp = softplusf_(-lam[c]);
    float x3 = 0.f, x2 = 0.f, x1 = 0.f, hst = 0.f;
    __syncthreads();
    for (int t = 0; t < T_; ++t) {
        const bf16_t* row = proj + ((size_t)b * T_ + t) * P1;
        const float xr = bf2f(row[c]);
        const float xc = w0 * x3 + w1 * x2 + w2 * x1 + w3 * xr + cb; x3 = x2; x2 = x1; x1 = xr;
        xcs[lane] = xc;
        __syncthreads();
        float ga = bav, gx = bxv;
#pragma unroll 16
        for (int i = 0; i < 64; ++i) { const float xv = xcs[i]; ga += xv * WA[i][lane]; gx += xv * WX[i][lane]; }
        __syncthreads();
        const float r = sigmoidf_(ga), ii = sigmoidf_(gx);
        const float la = -8.f * r * sp, a = expf(la);
        const float u = sqrtf(fmaxf(-expm1f(2.f * la), 1e-12f)) * (ii * xc);
        hst = a * hst + u;
        mix[((size_t)b * T_ + t) * D_ + c] = f2bf(bf2f(row[512 + c]) * hst);
    }
}

__global__ void __launch_bounds__(256) nsb(const bf16_t* proj, bf16_t* mix) {
    const int lane = threadIdx.x & 63, rid = blockIdx.x * 4 + (threadIdx.x >> 6);
    const int h = rid & 7, tokn = rid >> 3, b = tokn >> 12, i = tokn & 4095;
    const bf16_t* qrow = proj + (size_t)tokn * P1 + 1024 + h * 64;
    const size_t rb = (size_t)b * T_;
    float o = 0.f, carry = 0.f;
    for (int jb = (i - 1) >> 6; jb >= 0 && i > 0; --jb) {
        const int j = jb * 64 + lane; const bool valid = j < i;
        const bf16_t* krow = proj + (rb + (valid ? j : 0)) * P1 + 1536 + h * 64;
        float z = 0.f;
        for (int d = 0; d < 64; ++d) z += bf2f(qrow[d]) * bf2f(krow[d]);
        z *= LN2F;
        const float spz = softplusf_(z);
        const float l1m = valid ? -spz : 0.f;
        float inc = l1m;
#pragma unroll
        for (int off = 1; off < 64; off <<= 1) { const float t = __shfl_down(inc, off); if (lane + off < 64) inc += t; }
        const float after = carry + (inc - l1m);
        const float a = valid ? expf((z - spz) + after) : 0.f;
        carry += __shfl(inc, 0);
        const int jmax = min(64, i - jb * 64);
        for (int jj = 0; jj < jmax; ++jj) { const float aj = __shfl(a, jj); o += aj * bf2f(proj[(rb + jb * 64 + jj) * P1 + 2048 + h * 64 + lane]); }
    }
    mix[(size_t)tokn * D_ + 512 + h * 64 + lane] = f2bf(o);
}

__global__ void __launch_bounds__(256) nmoe(const bf16_t* H, const TokInfo* tok, const bf16_t* GU, const bf16_t* DN, bf16_t* ymoe) {
    __shared__ float hs[1024], he[512];
    const int tid = threadIdx.x, m = blockIdx.x;
    for (int i = tid; i < 1024; i += 256) hs[i] = bf2f(H[(size_t)m * D_ + i]);
    const TokInfo ti = tok[m];
    float y[4] = {0.f, 0.f, 0.f, 0.f};
    __syncthreads();
    for (int k = 0; k < 2; ++k) {
        const int e = (k == 0 ? ti.ep1 : ti.ep2) >> 20; const float w = k == 0 ? ti.w1 : ti.w2;
        for (int jj = 0; jj < 2; ++jj) { const int j = tid + 256 * jj; const int rg = 256 * (j >> 7) + (j & 127);
            const bf16_t* gr = GU + ((size_t)e * 1024 + rg) * 1024, * ur = gr + 128 * 1024;
            float g = 0.f, u = 0.f;
            for (int kk = 0; kk < 1024; kk += 8) { const bf16x8 gv = *(const bf16x8*)(gr + kk), uv = *(const bf16x8*)(ur + kk);
#pragma unroll
                for (int i = 0; i < 8; ++i) { g += hs[kk + i] * bf2f((bf16_t)gv[i]); u += hs[kk + i] * bf2f((bf16_t)uv[i]); } }
            he[j] = bf2f(f2bf(siluf_(g) * u)); }
        __syncthreads();
        for (int nn = 0; nn < 4; ++nn) { const int n = tid + 256 * nn; const bf16_t* dr = DN + ((size_t)e * 1024 + n) * 512; float s = 0.f;
            for (int kk = 0; kk < 512; kk += 8) { const bf16x8 dv = *(const bf16x8*)(dr + kk);
#pragma unroll
                for (int i = 0; i < 8; ++i) s += he[kk + i] * bf2f((bf16_t)dv[i]); }
            y[nn] += w * s; }
        __syncthreads();
    }
    for (int nn = 0; nn < 4; ++nn) ymoe[(size_t)m * D_ + tid + 256 * nn] = f2bf(y[nn]);
}

namespace pg8 {
constexpr int BM = 256, BK = 64, HALF = 128, HTB = HALF * BK * 2, STAGE_BYTES = 8 * HTB, NXCD = 8, WGM = 8;
__host__ __device__ __forceinline__ int lds_byte(int r, int c) { const int st = (r >> 4) * 2 + (c >> 5), rr = r & 15, cc = c & 31, ob = rr * 64 + cc * 2; return st * 1024 + (ob ^ (((ob >> 9) & 1) << 5)); }
__host__ __device__ __forceinline__ void stage_rc(int b, int& R, int& C) { const int st = b / 1024, sb = b % 1024, swz = sb ^ (((sb >> 9) & 1) << 5); R = (st >> 1) * 16 + swz / 64; C = (st & 1) * 32 + (swz % 64) / 2; }
__host__ __device__ __forceinline__ int perm32(int rho) { const int n = rho >> 4, i = rho & 15; return 8 * (i >> 2) + 4 * n + (i & 3); }
struct Unit { int pm, pn, e, nvalid; const int* rowmap; };
struct Gemm { const bf16_t* A; const bf16_t* Bt; int K; size_t bstride; };

struct StaticOrder {
    int nM, nN, nwg, G, c;
    __device__ void init(int M, int N, int G_, int c_) { nM = M / BM; nN = N / BM; nwg = nM * nN; G = G_; c = c_; }
    __device__ bool next(int i, Unit& u) const {
        const long L = (long)i * G + c; if (L >= nwg) return false;
        int wgid = (int)L; { const int q = nwg / NXCD, r = nwg % NXCD, xcd = wgid % NXCD, off = wgid / NXCD; wgid = (xcd < r ? xcd * (q + 1) : r * (q + 1) + (xcd - r) * q) + off; }
        const int nig = WGM * nN, gid = wgid / nig, fm = gid * WGM, gsz = (nM - fm) < WGM ? (nM - fm) : WGM;
        u.pm = fm + ((wgid % nig) % gsz); u.pn = (wgid % nig) / gsz; u.e = 0; u.nvalid = 256; u.rowmap = nullptr; return true;
    }
};
struct MoeOrder {
    const LAS int* tab; const int* list; int G, c, npn;
    __device__ bool next(int i, Unit& u) const {
        const int L = i * G + c; const int total = tab[16] * npn; if (L >= total) return false;
        const int tile = L / npn; u.pn = L - tile * npn; int e = 0;
#pragma unroll
        for (int j = 1; j < 16; ++j) e += (tile >= tab[j]) ? 1 : 0;
        const int mt = tile - tab[e]; u.pm = tile; u.e = e; const int rem = tab[32 + e] - mt * 256; u.nvalid = rem < 256 ? rem : 256;
        u.rowmap = list + (size_t)e * M_ + mt * 256; return true;
    }
};

template <int MODE> __device__ __forceinline__ f32x4 act4(f32x4 v, float qs) {
    if (MODE == 1) return v * qs;
    if (MODE == 2) { f32x4 o; o[0] = siluf_(v[0]); o[1] = siluf_(v[1]); o[2] = siluf_(v[2]); o[3] = siluf_(v[3]); return o; }
    if (MODE == 3) { f32x4 o; o[0] = gelu_t(v[0]); o[1] = gelu_t(v[1]); o[2] = gelu_t(v[2]); o[3] = gelu_t(v[3]); return o; }
    return v;
}
struct EpiAct {
    static constexpr bool PERM = true;
    bf16_t* O; int ldc; unsigned long long modes; float qs;
    template <int MODE> __device__ __forceinline__ void store(const f32x4 (&acc)[2][2][4][2], const Unit& u, int wr, int wc, int fr, int fq) const {
        const int row0 = u.pm * BM + wr * 64 + fr, col0 = u.pn * BM + wc * 32 + 8 * fq;
#pragma unroll
        for (int ai = 0; ai < 2; ++ai)
#pragma unroll
            for (int m = 0; m < 4; ++m) { bf16_t* rowp = O + (size_t)(row0 + ai * HALF + m * 16) * ldc + col0;
#pragma unroll
                for (int bj = 0; bj < 2; ++bj) { const f32x4 v0 = act4<MODE>(acc[ai][bj][m][0], qs), v1 = act4<MODE>(acc[ai][bj][m][1], qs);
                    u32x4 w; w.x = cvt_pk_bf16(v0[0], v0[1]); w.y = cvt_pk_bf16(v0[2], v0[3]); w.z = cvt_pk_bf16(v1[0], v1[1]); w.w = cvt_pk_bf16(v1[2], v1[3]);
                    *(u32x4*)(rowp + bj * HALF) = w; } }
    }
    __device__ __forceinline__ void operator()(const f32x4 (&acc)[2][2][4][2], const Unit& u, int wr, int wc, int fr, int fq) const {
        const int mode = (int)((modes >> (4 * u.pn)) & 15ull);
        if (mode == 0) store<0>(acc, u, wr, wc, fr, fq); else if (mode == 1) store<1>(acc, u, wr, wc, fr, fq); else if (mode == 2) store<2>(acc, u, wr, wc, fr, fq); else store<3>(acc, u, wr, wc, fr, fq);
    }
};
struct EpiGU {
    static constexpr bool PERM = true;
    bf16_t* O;
    __device__ __forceinline__ void operator()(const f32x4 (&acc)[2][2][4][2], const Unit& u, int wr, int wc, int fr, int fq) const {
        const int row0 = u.pm * BM + wr * 64 + fr, col0 = u.pn * HALF + wc * 32 + 8 * fq;
#pragma unroll
        for (int ai = 0; ai < 2; ++ai)
#pragma unroll
            for (int m = 0; m < 4; ++m) { f32x4 v0 = act4<2>(acc[ai][0][m][0], 1.f) * acc[ai][1][m][0], v1 = act4<2>(acc[ai][0][m][1], 1.f) * acc[ai][1][m][1];
                u32x4 w; w.x = cvt_pk_bf16(v0[0], v0[1]); w.y = cvt_pk_bf16(v0[2], v0[3]); w.z = cvt_pk_bf16(v1[0], v1[1]); w.w = cvt_pk_bf16(v1[2], v1[3]);
                *(u32x4*)(O + (size_t)(row0 + ai * HALF + m * 16) * 512 + col0) = w; }
    }
};

template <class Epi, class Sched, bool ALIGN_EPI, bool GATHER>
__device__ __forceinline__ void gemm_phase(LAS unsigned char* lds, const Gemm g, const Sched& S, const Epi& E) {
    const int tid = threadIdx.x, wid = __builtin_amdgcn_readfirstlane(tid >> 6), lane = tid & 63, wr = wid >> 2, wc = wid & 3, fr = lane & 15, fq = lane >> 4;
    const int K = g.K, nt = K / BK;
    int Rst[2], Cst[2]; unsigned voffB[2];
#pragma unroll
    for (int i = 0; i < 2; ++i) { int R, C; stage_rc(tid * 16 + i * 8192, R, C); const int Rb = Epi::PERM ? ((R & ~31) + perm32(R & 31)) : R;
        Rst[i] = R; Cst[i] = C; voffB[i] = (unsigned)(Rb * K + C) * 2u; }
    const size_t kstep = (size_t)(BK * 2);
    const size_t hstep = (size_t)HALF * K * 2;
    const size_t tstep = 2 * hstep;
    const unsigned ldsw = (unsigned)wid * 1024u;
    const int aoff = lds_byte(wr * 64 + fr, fq * 8), boff = lds_byte(wc * 32 + fr, fq * 8);
#define PG8_SA(b, h) (((b) * 2 + (h)) * HTB)
#define PG8_SB(b, h) ((4 + (b) * 2 + (h)) * HTB)
#define PG8_STAGE(bufoff, gbase, voff) do { _Pragma("unroll") for (int _i = 0; _i < 2; ++_i) \
        __builtin_amdgcn_global_load_lds((const unsigned*)((const char*)(gbase) + (voff)[_i]), (LAS unsigned*)(lds + (bufoff) + ldsw + _i * 8192), 16, 0, 0); } while (0)
#define PG8_LDA(dst, b, h) do { _Pragma("unroll") for (int m = 0; m < 4; ++m) _Pragma("unroll") for (int k = 0; k < 2; ++k) dst[m][k] = *(const LAS bf16x8*)(lds + PG8_SA(b, h) + aoff + m * 2048 + k * 1024); } while (0)
#define PG8_LDB(dst, b, h) do { _Pragma("unroll") for (int n = 0; n < 2; ++n) _Pragma("unroll") for (int k = 0; k < 2; ++k) dst[n][k] = *(const LAS bf16x8*)(lds + PG8_SB(b, h) + boff + n * 2048 + k * 1024); } while (0)
#define PG8_MMA(ai, bj, At, Bt) do { __builtin_amdgcn_s_setprio(1); _Pragma("unroll") for (int m = 0; m < 4; ++m) _Pragma("unroll") for (int n = 0; n < 2; ++n) _Pragma("unroll") for (int k = 0; k < 2; ++k) \
        acc[ai][bj][m][n] = __builtin_amdgcn_mfma_f32_16x16x32_bf16(Bt[n][k], At[m][k], acc[ai][bj][m][n], 0, 0, 0); __builtin_amdgcn_s_setprio(0); } while (0)
#define PG8_WAIT_V(n) asm volatile("s_waitcnt vmcnt(" #n ")" ::: "memory")
#define PG8_WAIT_L(n) asm volatile("s_waitcnt lgkmcnt(" #n ")" ::: "memory")
#define PG8_BAR __builtin_amdgcn_s_barrier()
#define PG8_SCHED __builtin_amdgcn_sched_barrier(0)
#define PG8_VOA(vo, un) do { _Pragma("unroll") for (int _h = 0; _h < 2; ++_h) _Pragma("unroll") for (int _i = 0; _i < 2; ++_i) { \
        if constexpr (GATHER) { const int _r = _h * HALF + Rst[_i]; const int _row = (_r < (un).nvalid) ? (un).rowmap[_r] : 0; vo[_h][_i] = (unsigned)(_row * K + Cst[_i]) * 2u; } \
        else vo[_h][_i] = (unsigned)(Rst[_i] * K + Cst[_i]) * 2u + (unsigned)(_h * hstep); } } while (0)
    Unit cur, nxt; int ui = 0;
    if (!S.next(0, cur)) return;
    f32x4 acc[2][2][4][2];
#pragma unroll
    for (int a = 0; a < 2; ++a)
#pragma unroll
        for (int b = 0; b < 2; ++b)
#pragma unroll
            for (int m = 0; m < 4; ++m)
#pragma unroll
                for (int n = 0; n < 2; ++n) acc[a][b][m][n] = (f32x4){0.f, 0.f, 0.f, 0.f};
    bf16x8 At[4][2], B0[2][2], B1[2][2];
    unsigned voA[2][2], voN[2][2];
    PG8_VOA(voA, cur);
    const char* cA = GATHER ? (const char*)g.A : (const char*)g.A + (size_t)cur.pm * tstep;
    const char* cB = (const char*)g.Bt + ((size_t)cur.e * g.bstride) * 2 + (size_t)cur.pn * tstep;
    PG8_STAGE(PG8_SB(0, 0), cB, voffB); PG8_STAGE(PG8_SB(0, 1), cB + hstep, voffB); PG8_STAGE(PG8_SA(0, 0), cA, voA[0]); PG8_STAGE(PG8_SA(0, 1), cA, voA[1]);
    if (wr == 1) PG8_BAR;
    PG8_WAIT_V(2); PG8_BAR;
    PG8_STAGE(PG8_SB(1, 0), cB + kstep, voffB); PG8_STAGE(PG8_SA(1, 0), cA + kstep, voA[0]); PG8_STAGE(PG8_SB(1, 1), cB + hstep + kstep, voffB);
    PG8_WAIT_V(6); PG8_BAR;
    for (;;) {
        const bool has_next = S.next(ui + 1, nxt);
        const char* nA = cA; const char* nB = cB;
        if (has_next) { nA = GATHER ? (const char*)g.A : (const char*)g.A + (size_t)nxt.pm * tstep; nB = (const char*)g.Bt + ((size_t)nxt.e * g.bstride) * 2 + (size_t)nxt.pn * tstep; PG8_VOA(voN, nxt); }
        else {
#pragma unroll
            for (int _h = 0; _h < 2; ++_h)
#pragma unroll
                for (int _i = 0; _i < 2; ++_i) voN[_h][_i] = voA[_h][_i]; }
        for (int t = 0; t < nt; t += 2) {
            const bool last = (t == nt - 2);
            const char* a1 = cA + (size_t)(t + 1) * kstep;
            const char* a2 = last ? nA : cA + (size_t)(t + 2) * kstep; const char* b2 = last ? nB : cB + (size_t)(t + 2) * kstep;
            const char* a3 = a2 + kstep; const char* b3 = b2 + kstep;
            unsigned vo2[2][2];
#pragma unroll
            for (int _h = 0; _h < 2; ++_h)
#pragma unroll
                for (int _i = 0; _i < 2; ++_i) vo2[_h][_i] = last ? voN[_h][_i] : voA[_h][_i];
            PG8_LDB(B0, 0, 0); PG8_LDB(B1, 0, 1); PG8_SCHED; PG8_LDA(At, 0, 0); PG8_STAGE(PG8_SA(1, 1), a1, voA[1]);
            PG8_WAIT_V(8); PG8_WAIT_L(0); PG8_BAR; PG8_MMA(0, 0, At, B0); PG8_MMA(0, 1, At, B1); PG8_BAR; PG8_SCHED;
            PG8_LDA(At, 0, 1); PG8_STAGE(PG8_SB(0, 0), b2, voffB); PG8_STAGE(PG8_SB(0, 1), b2 + hstep, voffB); PG8_STAGE(PG8_SA(0, 0), a2, vo2[0]);
            PG8_WAIT_V(8); PG8_WAIT_L(0); PG8_BAR; PG8_MMA(1, 0, At, B0); PG8_MMA(1, 1, At, B1); PG8_BAR; PG8_SCHED;
            PG8_LDB(B0, 1, 0); PG8_LDB(B1, 1, 1); PG8_SCHED; PG8_LDA(At, 1, 0); PG8_STAGE(PG8_SA(0, 1), a2, vo2[1]);
            PG8_WAIT_V(8); PG8_WAIT_L(0); PG8_BAR; PG8_MMA(0, 0, At, B0); PG8_MMA(0, 1, At, B1); PG8_BAR; PG8_SCHED;
            PG8_LDA(At, 1, 1); PG8_STAGE(PG8_SB(1, 0), b3, voffB); PG8_STAGE(PG8_SB(1, 1), b3 + hstep, voffB); PG8_STAGE(PG8_SA(1, 0), a3, vo2[0]);
            PG8_WAIT_V(8); PG8_WAIT_L(0); PG8_BAR; PG8_MMA(1, 0, At, B0); PG8_MMA(1, 1, At, B1); PG8_BAR; PG8_SCHED;
        }
        if constexpr (ALIGN_EPI) { if (wr == 0) PG8_BAR; }
        E(acc, cur, wr, wc, fr, fq);
        if (!has_next) break;
#pragma unroll
        for (int a = 0; a < 2; ++a)
#pragma unroll
            for (int b = 0; b < 2; ++b)
#pragma unroll
                for (int m = 0; m < 4; ++m)
#pragma unroll
                    for (int n = 0; n < 2; ++n) acc[a][b][m][n] = (f32x4){0.f, 0.f, 0.f, 0.f};
        cur = nxt; cA = nA; cB = nB; ++ui;
#pragma unroll
        for (int _h = 0; _h < 2; ++_h)
#pragma unroll
            for (int _i = 0; _i < 2; ++_i) voA[_h][_i] = voN[_h][_i];
        if constexpr (ALIGN_EPI) { if (wr == 1) PG8_BAR; }
    }
    PG8_WAIT_V(0);
    if constexpr (!ALIGN_EPI) { if (wr == 0) PG8_BAR; }
    PG8_BAR;
#undef PG8_SA
#undef PG8_SB
#undef PG8_STAGE
#undef PG8_LDA
#undef PG8_LDB
#undef PG8_MMA
#undef PG8_WAIT_V
#undef PG8_WAIT_L
#undef PG8_BAR
#undef PG8_SCHED
#undef PG8_VOA
}
}

constexpr int LDS_CTL_Q = 131072 + 512;
namespace att {
typedef short v4i16 __attribute__((ext_vector_type(4)));
__device__ __forceinline__ int crow(int r, int hi) { return (r & 3) + 8 * (r >> 2) + 4 * hi; }
__device__ __forceinline__ bf16x8 vtr2(const LAS unsigned char* p) {
    const v4i16 lo = __builtin_amdgcn_ds_read_tr16_b64_v4i16((LAS v4i16*)p), hi = __builtin_amdgcn_ds_read_tr16_b64_v4i16((LAS v4i16*)(p + 512));
    return (bf16x8){lo[0], lo[1], lo[2], lo[3], hi[0], hi[1], hi[2], hi[3]};
}
__device__ __forceinline__ bf16x8 pack8(const f32x16& p, int b) {
    u32x4 w; w.x = cvt_pk_bf16(p[b], p[b + 1]); w.y = cvt_pk_bf16(p[b + 2], p[b + 3]); w.z = cvt_pk_bf16(p[b + 4], p[b + 5]); w.w = cvt_pk_bf16(p[b + 6], p[b + 7]);
    return __builtin_bit_cast(bf16x8, w);
}
__device__ __forceinline__ float swapmax(float v) { auto rr = __builtin_amdgcn_permlane32_swap(__float_as_uint(v), __float_as_uint(v), false, false); return fmaxf(__uint_as_float(rr[0]), __uint_as_float(rr[1])); }
__device__ __forceinline__ float swapsum(float v) { auto rr = __builtin_amdgcn_permlane32_swap(__float_as_uint(v), __float_as_uint(v), false, false); return __uint_as_float(rr[0]) + __uint_as_float(rr[1]); }
#ifdef DBG_NO_DMA
#define GLDS16(g, l) (*(LAS u32x4*)((l) + (threadIdx.x & 63) * 16) = *(const u32x4*)(g))
#else
#define GLDS16(g, l) __builtin_amdgcn_global_load_lds((const unsigned*)(g), (LAS unsigned*)(l), 16, 0, 0)
#endif

constexpr float DA_THR = 8.f;
#ifndef DA_EXIT
#define DA_EXIT 48.f
#endif
__device__ const unsigned char da_order[128] = {127,126,125,124,123,122,121,120,119,86,87,88,89,90,91,92,93,94,95,118,85,117,84,116,83,115,82,114,81,113,80,112,79,111,78,110,77,109,76,108,75,107,74,106,73,105,72,104,71,103,38,39,40,41,42,43,44,45,46,47,48,49,50,51,52,53,54,55,56,57,58,59,60,61,62,63,70,102,37,69,101,36,68,100,35,67,99,2,3,4,5,6,7,8,9,10,11,12,13,14,15,16,17,18,19,20,21,22,23,24,25,26,27,28,29,30,31,34,66,98,1,33,65,97,0,32,64,96};
__device__ __forceinline__ void da_kmax(const Ptrs& P, LAS unsigned char* lds, int vcu, int G) {
    const int tid = threadIdx.x, lane = tid & 63;
    const bf16_t* proj = (const bf16_t*)(P.ws + WS_P);
    unsigned* km = (unsigned*)(P.ws + WS_CTL) + CW_KMAX;
    for (int u = vcu; u < 256; u += G) {
        const int bh = u >> 3, e8 = u & 7, b = bh >> 2, h = bh & 3;
        float mx = 0.f; const int c = tid & 1;
        for (int r = tid >> 1; r < 512; r += 256) { const bf16_t* kp = proj + ((size_t)b * T_ + e8 * 512 + r) * P0 + 512 + h * 128 + c * 64; float q = 0.f;
#pragma unroll
            for (int i = 0; i < 8; ++i) { const bf16x8 v = *(const bf16x8*)(kp + 8 * i);
#pragma unroll
                for (int k = 0; k < 8; ++k) { const float f = bf2f((bf16_t)v[k]); q += f * f; } }
            mx = fmaxf(mx, q); }
#pragma unroll
        for (int o = 2; o < 64; o <<= 1) mx = fmaxf(mx, __shfl_xor(mx, o));
        if (lane < 2) atomicMax(km + bh * 2 + lane, __float_as_uint(sqrtf(mx)));
    }
}
__device__ __forceinline__ void da_unit(LAS unsigned char* lds, const bf16_t* proj, bf16_t* mix, int b, int h, int qb, float lam, const float* gainp, const unsigned* kmaxp) {
    const int tid = threadIdx.x, lane = tid & 63, wid = __builtin_amdgcn_readfirstlane(tid >> 6), r32 = lane & 31, hi = lane >> 5;
    const int rg = wid & 3, c = wid >> 2;
    const size_t rowbase = (size_t)b * T_;
    const int i0w = qb * 128 + rg * 32;
    const float slope2 = exp2f(-2.f * (float)(h + 1)) * LOG2E;
    LAS float* wsf = (LAS float*)(lds + 65536) + wid * 64;
    LAS float* flg = (LAS float*)(lds + 65536 + 2048);
    bf16x8 qf[4]; float qk;
    { const bf16_t* qp = proj + (rowbase + i0w + r32) * P0 + h * 128 + c * 64 + hi * 8; float q2 = 0.f;
#pragma unroll
      for (int s = 0; s < 4; ++s) { qf[s] = *(const bf16x8*)(qp + s * 16);
#pragma unroll
          for (int k = 0; k < 8; ++k) { const float f = bf2f((bf16_t)qf[s][k]); q2 += f * f; } }
      qk = sqrtf(swapsum(q2)) * __uint_as_float(__hip_atomic_load(kmaxp + ((b * 4 + h) * 2 + c), __ATOMIC_RELAXED, __HIP_MEMORY_SCOPE_AGENT)) * 1.01f + 0.01f; }
    f32x16 o[4];
#pragma unroll
    for (int d = 0; d < 4; ++d)
#pragma unroll
        for (int r = 0; r < 16; ++r) o[d][r] = 0.f;
    float mrun = -1e30f, lrun = 0.f;
    const int nt = 2 * qb + 2;
    const bf16_t* ksrc[2]; const bf16_t* vsrc[2];
    { const int key = tid >> 3, chp = tid & 7;
#pragma unroll
      for (int i = 0; i < 2; ++i) ksrc[i] = proj + (rowbase + key) * P0 + 512 + h * 128 + i * 64 + ((chp ^ (key & 7)) * 8);
      const int ks = (tid >> 6) & 3, sub = (tid >> 5) & 1, row = (tid >> 2) & 7, cq = tid & 3, vkey = ks * 16 + sub * 8 + row;
#pragma unroll
      for (int i = 0; i < 2; ++i) vsrc[i] = proj + (rowbase + vkey) * P0 + 1024 + h * 128 + (i * 2 + (tid >> 8)) * 32 + cq * 8; }
    const unsigned ldsw = (unsigned)wid * 1024u;
#define DA_ISSUE(jt, sb) do { const size_t _o = (size_t)(jt) * 64 * P0; \
        GLDS16(ksrc[0] + _o, lds + (sb) * 32768 + ldsw); GLDS16(ksrc[1] + _o, lds + (sb) * 32768 + 8192 + ldsw); \
        GLDS16(vsrc[0] + _o, lds + (sb) * 32768 + 16384 + ldsw); GLDS16(vsrc[1] + _o, lds + (sb) * 32768 + 24576 + ldsw); } while (0)
    const int koff = c * 8192 + r32 * 128, kx = r32 & 7;
    const int voff = 16384 + ((lane >> 4) & 1) * 32 + (lane & 3) * 8 + (4 * hi + ((lane & 15) >> 2)) * 64;
    DA_ISSUE(nt - 1, 0);
    __syncthreads();
    for (int it = 0; it < nt; ++it) {
        const int jt = nt - 1 - it, sb = it & 1;
        if (it + 1 < nt) DA_ISSUE(jt - 1, sb ^ 1);
        const int j0 = jt * 64, dj = j0 - i0w;
        if (dj <= 31) {
            const LAS unsigned char* kb = lds + sb * 32768 + koff;
            f32x16 p0, p1;
            const float bbase = slope2 * (float)(dj + 4 * hi);
#pragma unroll
            for (int r = 0; r < 16; ++r) { p0[r] = fmaf(slope2, (float)((r & 3) + 8 * (r >> 2)), bbase); p1[r] = p0[r] + 32.f * slope2; }
#pragma unroll
            for (int s = 0; s < 4; ++s) {
                const bf16x8 ka = *(const LAS bf16x8*)(kb + (((2 * s + hi) ^ kx) << 4));
                const bf16x8 kb2 = *(const LAS bf16x8*)(kb + 4096 + (((2 * s + hi) ^ kx) << 4));
                p0 = __builtin_amdgcn_mfma_f32_32x32x16_bf16(ka, qf[s], p0, 0, 0, 0);
                p1 = __builtin_amdgcn_mfma_f32_32x32x16_bf16(kb2, qf[s], p1, 0, 0, 0);
            }
            if (dj + 63 > 0) {
#pragma unroll
                for (int r = 0; r < 16; ++r) { const int kk = dj + (r & 3) + 8 * (r >> 2) + 4 * hi; if (kk > r32) p0[r] = -INFINITY; if (kk + 32 > r32) p1[r] = -INFINITY; }
            }
            float mx = fmaxf(p0[0], p1[0]);
#pragma unroll
            for (int r = 1; r < 16; ++r) mx = fmaxf(mx, fmaxf(p0[r], p1[r]));
            mx = swapmax(mx);
            if (__any(mx > mrun + DA_THR)) {
                const float mn = fmaxf(mrun, mx), f = fexp2(mrun - mn);
                lrun *= f; mrun = mn;
                if (hi == 0) wsf[r32] = f;
#pragma unroll
                for (int r = 0; r < 16; ++r) { const float fr = wsf[crow(r, hi)];
#pragma unroll
                    for (int d = 0; d < 4; ++d) o[d][r] *= fr; }
            }
            float sum = 0.f;
#pragma unroll
            for (int r = 0; r < 16; ++r) { p0[r] = fexp2(p0[r] - mrun); p1[r] = fexp2(p1[r] - mrun); sum += p0[r] + p1[r]; }
            lrun += sum;
            bf16x8 pa[4];
            pa[0] = pack8(p0, 0); pa[1] = pack8(p0, 8); pa[2] = pack8(p1, 0); pa[3] = pack8(p1, 8);
            const LAS unsigned char* vb = lds + sb * 32768 + voff;
#pragma unroll
            for (int d = 0; d < 4; ++d)
#pragma unroll
                for (int s = 0; s < 4; ++s) { const bf16x8 vf = vtr2(vb + d * 4096 + s * 1024);
                    o[d] = __builtin_amdgcn_mfma_f32_32x32x16_bf16(pa[s], vf, o[d], 0, 0, 0); }
        }
        { const bool fin = (qk + slope2 * (float)(dj - 1)) < (mrun - DA_EXIT); const bool allfin = __all(fin); if (lane == 0) flg[sb * 8 + wid] = allfin ? 1.f : 0.f; }
        __syncthreads();
        { const LAS float* f = flg + sb * 8; const float a = (f[0] + f[1]) + (f[2] + f[3]) + (f[4] + f[5]) + (f[6] + f[7]); if (a > 7.5f) break; }
    }
#undef DA_ISSUE
    __syncthreads();
    const float lt = swapsum(lrun);
    if (hi == 0) wsf[r32] = (c == 0 ? 1.f : lam) / lt;
    LAS float* xch = (LAS float*)lds + rg * 4096 + lane;
#pragma unroll
    for (int r = 0; r < 16; ++r) { const float cf = wsf[crow(r, hi)];
#pragma unroll
        for (int d = 0; d < 4; ++d) { o[d][r] *= cf; if (c == 1) xch[(d * 16 + r) * 64] = o[d][r]; } }
    __syncthreads();
    if (c == 0) {
        float ssq[16];
#pragma unroll
        for (int r = 0; r < 16; ++r) { float q = 0.f;
#pragma unroll
            for (int d = 0; d < 4; ++d) { const float v = o[d][r] - xch[(d * 16 + r) * 64]; o[d][r] = v; q += v * v; }
            ssq[r] = q; }
#pragma unroll
        for (int r = 0; r < 16; ++r) {
#pragma unroll
            for (int off = 1; off < 32; off <<= 1) ssq[r] += __shfl_xor(ssq[r], off);
            ssq[r] = (1.f - LAM_INIT0) / sqrtf(ssq[r] * (1.f / 128.f) + RMS_EPS); }
        float gn[4];
#pragma unroll
        for (int d = 0; d < 4; ++d) gn[d] = gainp[d * 32 + r32];
#pragma unroll
        for (int r = 0; r < 16; ++r) { bf16_t* orow = mix + (rowbase + i0w + crow(r, hi)) * D_ + h * 128 + r32;
#pragma unroll
            for (int d = 0; d < 4; ++d) orow[d * 32] = f2bf(o[d][r] * ssq[r] * gn[d]); }
    }
    __syncthreads();
}
__device__ __forceinline__ void ph_diffattn(const Ptrs& P, LAS unsigned char* lds) {
    const int lane = threadIdx.x & 63;
    const float* dl = P.in[8];
    const float d01 = wave_sum(dl[lane] * dl[64 + lane]), d23 = wave_sum(dl[128 + lane] * dl[192 + lane]);
    const float lam = expf(d01) - expf(d23) + LAM_INIT0;
    unsigned* qh = (unsigned*)(P.ws + WS_CTL) + CW_DAQ;
    LAS int* slot = (LAS int*)(lds + LDS_CTL_Q);
    for (;;) {
        if (threadIdx.x == 0) slot[0] = (int)__hip_atomic_fetch_add(qh, 1u, __ATOMIC_RELAXED, __HIP_MEMORY_SCOPE_AGENT);
        __syncthreads();
        const int n = slot[0];
        __syncthreads();
        if (n >= 1024) break;
        const int hq = da_order[n >> 3], b = n & 7;
        da_unit(lds, (const bf16_t*)(P.ws + WS_P), (bf16_t*)(P.ws + WS_H), b, hq >> 5, hq & 31, lam, P.in[9], (const unsigned*)(P.ws + WS_CTL) + CW_KMAX);
    }
}

#ifndef SB_EXIT
#define SB_EXIT 1e-30f
#endif
__device__ __forceinline__ void sb_pair(LAS unsigned char* lds, const bf16_t* proj, bf16_t* mix, int b, int h, int qb0, int qb1) {
    const int tid = threadIdx.x, lane = tid & 63, wid = __builtin_amdgcn_readfirstlane(tid >> 6), r32 = lane & 31, hi = lane >> 5;
    const int gsel = wid >> 2, wl = wid & 3, qb = gsel ? qb1 : qb0;
    const size_t rowbase = (size_t)b * T_;
    const int i0w = qb * 128 + wl * 32;
    LAS unsigned char* gl = lds + gsel * 32768;
    LAS float* flg = (LAS float*)(lds + 65536);
    bf16x8 qf[4];
    { const bf16_t* qp = proj + (rowbase + i0w + r32) * P1 + 1024 + h * 64 + hi * 8;
#pragma unroll
      for (int s = 0; s < 4; ++s) qf[s] = *(const bf16x8*)(qp + s * 16); }
    f32x16 o[2];
#pragma unroll
    for (int d = 0; d < 2; ++d)
#pragma unroll
        for (int r = 0; r < 16; ++r) o[d][r] = 0.f;
    float Rrun = 1.f;
    const int nt = 2 * qb + 2, nt0 = 2 * qb0 + 2, nt1 = 2 * qb1 + 2;
    const bf16_t* ksrc[2]; const bf16_t* vsrc[2];
    { const int t = tid & 255;
#pragma unroll
      for (int i = 0; i < 2; ++i) { const int pp = i * 256 + t, key = pp >> 3, chp = pp & 7;
          ksrc[i] = proj + (rowbase + key) * P1 + 1536 + h * 64 + ((chp ^ (key & 7)) * 8);
          const int ks = t >> 6, sub = (t >> 5) & 1, row = (t >> 2) & 7, cq = t & 3, vkey = ks * 16 + sub * 8 + row;
          vsrc[i] = proj + (rowbase + vkey) * P1 + 2048 + h * 64 + i * 32 + cq * 8; } }
    const unsigned ldsw = (unsigned)wl * 1024u;
#define SB_ISSUE(jt, sb) do { const size_t _o = (size_t)(jt) * 64 * P1; GLDS16(ksrc[0] + _o, gl + (sb) * 16384 + ldsw); GLDS16(ksrc[1] + _o, gl + (sb) * 16384 + 4096 + ldsw); \
        GLDS16(vsrc[0] + _o, gl + (sb) * 16384 + 8192 + ldsw); GLDS16(vsrc[1] + _o, gl + (sb) * 16384 + 12288 + ldsw); } while (0)
    const int koff = r32 * 128, kx = r32 & 7;
    const int voff = 8192 + ((lane >> 4) & 1) * 32 + (lane & 3) * 8 + (4 * hi + ((lane & 15) >> 2)) * 64;
    SB_ISSUE(nt - 1, 0);
    __syncthreads();
    bool done0 = false, done1 = false;
    for (int it = 0;; ++it) {
        const int sb = it & 1; const bool act = !(gsel ? done1 : done0);
        const int jt = nt - 1 - it;
        if (act && it + 1 < nt) SB_ISSUE(jt - 1, sb ^ 1);
        const int j0 = jt * 64, dj = j0 - i0w;
        if (act && dj <= 30) {
            const LAS unsigned char* kb = gl + sb * 16384 + koff;
            f32x16 p0, p1;
#pragma unroll
            for (int r = 0; r < 16; ++r) { p0[r] = 0.f; p1[r] = 0.f; }
#pragma unroll
            for (int s = 0; s < 4; ++s) {
                const bf16x8 ka = *(const LAS bf16x8*)(kb + (((2 * s + hi) ^ kx) << 4));
                const bf16x8 kb2 = *(const LAS bf16x8*)(kb + 4096 + (((2 * s + hi) ^ kx) << 4));
                p0 = __builtin_amdgcn_mfma_f32_32x32x16_bf16(ka, qf[s], p0, 0, 0, 0);
                p1 = __builtin_amdgcn_mfma_f32_32x32x16_bf16(kb2, qf[s], p1, 0, 0, 0);
            }
            f32x16 q0, q1;
#pragma unroll
            for (int r = 0; r < 16; ++r) {
                const float e0 = fexp2(fminf(p0[r], 80.f)), e1 = fexp2(fminf(p1[r], 80.f));
                q0[r] = frcp(1.f + e0); q1[r] = frcp(1.f + e1); p0[r] = e0 * q0[r]; p1[r] = e1 * q1[r]; }
            if (dj + 63 >= 0) {
#pragma unroll
                for (int r = 0; r < 16; ++r) { const int kk = dj + (r & 3) + 8 * (r >> 2) + 4 * hi;
                    if (kk >= r32) { p0[r] = 0.f; q0[r] = 1.f; } if (kk + 32 >= r32) { p1[r] = 0.f; q1[r] = 1.f; } }
            }
            float Gown[8], Goth[8], Tsuf[8];
#pragma unroll
            for (int g = 0; g < 4; ++g) { Gown[g] = (q0[4 * g] * q0[4 * g + 1]) * (q0[4 * g + 2] * q0[4 * g + 3]); Gown[4 + g] = (q1[4 * g] * q1[4 * g + 1]) * (q1[4 * g + 2] * q1[4 * g + 3]); }
#pragma unroll
            for (int g = 0; g < 8; ++g) Goth[g] = swapother(Gown[g], hi);
            Tsuf[7] = 1.f;
#pragma unroll
            for (int g = 6; g >= 0; --g) Tsuf[g] = Tsuf[g + 1] * (Gown[g + 1] * Goth[g + 1]);
            const float tot = Tsuf[0] * (Gown[0] * Goth[0]);
#pragma unroll
            for (int g = 0; g < 4; ++g) {
                const float f0 = Rrun * Tsuf[g] * (hi ? 1.f : Goth[g]), f1 = Rrun * Tsuf[4 + g] * (hi ? 1.f : Goth[4 + g]);
                const float a3 = q0[4 * g + 3], a2 = a3 * q0[4 * g + 2], a1 = a2 * q0[4 * g + 1];
                p0[4 * g + 3] *= f0; p0[4 * g + 2] *= f0 * a3; p0[4 * g + 1] *= f0 * a2; p0[4 * g] *= f0 * a1;
                const float b3 = q1[4 * g + 3], b2 = b3 * q1[4 * g + 2], b1 = b2 * q1[4 * g + 1];
                p1[4 * g + 3] *= f1; p1[4 * g + 2] *= f1 * b3; p1[4 * g + 1] *= f1 * b2; p1[4 * g] *= f1 * b1;
            }
            Rrun *= tot;
            bf16x8 pa[4];
            pa[0] = pack8(p0, 0); pa[1] = pack8(p0, 8); pa[2] = pack8(p1, 0); pa[3] = pack8(p1, 8);
            const LAS unsigned char* vb = gl + sb * 16384 + voff;
#pragma unroll
            for (int d = 0; d < 2; ++d)
#pragma unroll
                for (int s = 0; s < 4; ++s) { const bf16x8 vf = vtr2(vb + d * 4096 + s * 1024);
                    o[d] = __builtin_amdgcn_mfma_f32_32x32x16_bf16(pa[s], vf, o[d], 0, 0, 0); }
        }
        { const float wm = act ? wave_max(Rrun) : 0.f; if (lane == 0) flg[sb * 8 + wid] = wm; }
        __syncthreads();
        { const LAS float* f = flg + sb * 8;
          const float m0 = fmaxf(fmaxf(f[0], f[1]), fmaxf(f[2], f[3])), m1 = fmaxf(fmaxf(f[4], f[5]), fmaxf(f[6], f[7]));
          done0 = done0 || (it + 1 >= nt0) || (m0 < SB_EXIT); done1 = done1 || (it + 1 >= nt1) || (m1 < SB_EXIT); }
        if (done0 && done1) break;
    }
#undef SB_ISSUE
    __syncthreads();
#pragma unroll
    for (int r = 0; r < 16; ++r) { bf16_t* orow = mix + (rowbase + i0w + crow(r, hi)) * D_ + 512 + h * 64 + r32;
#pragma unroll
        for (int d = 0; d < 2; ++d) orow[d * 32] = f2bf(o[d][r]); }
}
__device__ __forceinline__ void ph_sbattn(const Ptrs& P, LAS unsigned char* lds, int vcu, int G) {
    for (int u = vcu; u < 256; u += G) {
        const int bh = u >> 2, s = u & 3;
        for (int r = 0; r < 4; ++r) sb_pair(lds, (const bf16_t*)(P.ws + WS_P), (bf16_t*)(P.ws + WS_H), bh >> 3, bh & 7, s + 4 * r, s + 4 * (7 - r));
    }
}
}

namespace hg {
constexpr int QM = 0, KM = 17408, QB = 34816, KDT = 52224, VT = 70656, ATT = 89088, DEC = 98304, TOT = 98816, OO = 0;
constexpr int PQ = 272, PT = 144, PO = 528;
typedef float f32x4v __attribute__((ext_vector_type(4)));
__device__ __forceinline__ f32x4 mma16(bf16x8 a, bf16x8 b, f32x4 c) { return __builtin_amdgcn_mfma_f32_16x16x32_bf16(a, b, c, 0, 0, 0); }
template <bool STATS>
__device__ __forceinline__ void hg_unit(LAS unsigned char* lds, const Ptrs& P, int u) {
    const int tid = threadIdx.x, lane = tid & 63, wid = __builtin_amdgcn_readfirstlane(tid >> 6), l15 = lane & 15, g = lane >> 4;
    const int bh = u >> 3, seg = u & 7, b = bh >> 2, h = bh & 3;
    const bf16_t* proj = (const bf16_t*)(P.ws + WS_P);
    bf16_t* mix = (bf16_t*)(P.ws + WS_H);
    float* HGS = (float*)(P.ws + WS_HGS); float* HGD = (float*)(P.ws + WS_HGD);
    const int col = tid & 127, qtr = tid >> 7;
    float lb;
    { const float* gam = P.in[10]; const int c = h * 128 + col; const float g0 = gam[c], g1 = gam[512 + c], g2 = gam[1024 + c]; const float mx = fmaxf(g0, fmaxf(g1, g2));
      const float e0 = expf(g0 - mx), e1 = expf(g1 - mx), e2 = expf(g2 - mx); lb = e0 / (e0 + e1 + e2); }
    f32x4 S[8];
#pragma unroll
    for (int k = 0; k < 8; ++k) S[k] = (f32x4){0.f, 0.f, 0.f, 0.f};
    if (!STATS) {
        for (int j = 0; j < seg; ++j) { const int uj = bh * 8 + j;
            const f32x4* sp = (const f32x4*)(HGS + (size_t)uj * 16384) + (wid * 8) * 64 + lane; const float* dp = HGD + (size_t)uj * 128;
#pragma unroll
            for (int k = 0; k < 8; ++k) { const f32x4 d = *(const f32x4*)(dp + 16 * k + 4 * g); S[k] = S[k] * d + sp[k * 64]; } }
    }
    float sumlog = 0.f;
    for (int ch = 0; ch < 8; ++ch) {
        const size_t row0 = (size_t)b * T_ + seg * 512 + ch * 64 + qtr * 16;
        float cs[16], kk[16], qv[16], vv[16];
        { const bf16_t* pr = proj + row0 * P0 + h * 128 + col; float run = 0.f;
#pragma unroll
          for (int i = 0; i < 16; ++i) { const bf16_t* r = pr + (size_t)i * P0;
              const float fl = bf2f(r[2048]); const float f = lb + (1.f - lb) * sigmoidf_(fl);
              run += __builtin_amdgcn_logf(f) * LN2F; cs[i] = run; kk[i] = 1.f - f; vv[i] = bf2f(r[2560]); if (!STATS) qv[i] = bf2f(r[1536]); } }
        ((LAS float*)(lds + TOT))[qtr * 128 + col] = cs[15];
        __syncthreads();
        { const LAS float* tp = (const LAS float*)(lds + TOT) + col; const float t0 = tp[0], t1 = tp[128], t2 = tp[256], t3 = tp[384];
          const float off = (qtr > 0 ? t0 : 0.f) + (qtr > 1 ? t1 : 0.f) + (qtr > 2 ? t2 : 0.f), bmid = t0 + t1, blast = (t0 + t1) + (t2 + t3);
          const float emid = fexp(bmid), elm = fexp(blast - bmid);
          if (qtr == 0) { ((LAS float*)(lds + DEC))[col] = fexp(blast); sumlog += blast; }
#pragma unroll
          for (int i = 0; i < 16; ++i) { const int tok = qtr * 16 + i; const float bb = cs[i] + off; const float e1 = fexp(bb - bmid), e2 = frcp(e1);
              *(LAS bf16_t*)(lds + KDT + col * PT + tok * 2) = f2bf(kk[i] * e2 * elm);
              *(LAS bf16_t*)(lds + VT + col * PT + tok * 2) = f2bf(vv[i]);
              if (!STATS) { *(LAS bf16_t*)(lds + QM + tok * PQ + col * 2) = f2bf(qv[i] * e1); *(LAS bf16_t*)(lds + KM + tok * PQ + col * 2) = f2bf(kk[i] * e2);
                  *(LAS bf16_t*)(lds + QB + tok * PQ + col * 2) = f2bf(qv[i] * e1 * emid); } } }
        __syncthreads();
        f32x4 ao[4];
        if (!STATS) {
#pragma unroll
            for (int rep = 0; rep < 2; ++rep) { const int ti = wid + 8 * rep;
                if (ti < 10) { const int cb = ti < 1 ? 0 : ti < 3 ? 1 : ti < 6 ? 2 : 3; const int sb = ti - (cb * (cb + 1)) / 2;
                    f32x4 acc = (f32x4){0.f, 0.f, 0.f, 0.f};
#pragma unroll
                    for (int st = 0; st < 4; ++st) { const bf16x8 a = *(const LAS bf16x8*)(lds + QM + (16 * cb + l15) * PQ + (32 * st + 8 * g) * 2), bb = *(const LAS bf16x8*)(lds + KM + (16 * sb + l15) * PQ + (32 * st + 8 * g) * 2);
                        acc = mma16(a, bb, acc); }
#pragma unroll
                    for (int r = 0; r < 4; ++r) { float v = acc[r]; if (cb == sb && 4 * g + r < l15) v = 0.f; *(LAS bf16_t*)(lds + ATT + (16 * cb + 4 * g + r) * PT + (16 * sb + l15) * 2) = f2bf(v); } }
                else if (rep == 1 && wid >= 2) { const int zi = wid - 2; const int cb = zi < 3 ? 0 : zi < 5 ? 1 : 2; const int sb = zi < 3 ? zi + 1 : zi < 5 ? zi - 1 : 3;
#pragma unroll
                    for (int r = 0; r < 4; ++r) *(LAS bf16_t*)(lds + ATT + (16 * cb + 4 * g + r) * PT + (16 * sb + l15) * 2) = 0; } }
            bf16x8 Sb[4];
#pragma unroll
            for (int st = 0; st < 4; ++st) { u32x4 w; w.x = cvt_pk_bf16(S[2 * st][0], S[2 * st][1]); w.y = cvt_pk_bf16(S[2 * st][2], S[2 * st][3]); w.z = cvt_pk_bf16(S[2 * st + 1][0], S[2 * st + 1][1]); w.w = cvt_pk_bf16(S[2 * st + 1][2], S[2 * st + 1][3]); Sb[st] = __builtin_bit_cast(bf16x8, w); }
#pragma unroll
            for (int cb = 0; cb < 4; ++cb) { ao[cb] = (f32x4){0.f, 0.f, 0.f, 0.f};
#pragma unroll
                for (int st = 0; st < 4; ++st) { const LAS unsigned char* ap = lds + QB + (16 * cb + l15) * PQ + (32 * st + 4 * g) * 2;
                    const u32x2 lo = *(const LAS u32x2*)ap, hi2 = *(const LAS u32x2*)(ap + 32); const u32x4 w = {lo.x, lo.y, hi2.x, hi2.y};
                    ao[cb] = mma16(__builtin_bit_cast(bf16x8, w), Sb[st], ao[cb]); } }
        }
#pragma unroll
        for (int k = 0; k < 8; ++k) { const f32x4 d = *(const LAS f32x4*)(lds + DEC + (16 * k + 4 * g) * 4); S[k] = S[k] * d;
#pragma unroll
            for (int ks = 0; ks < 2; ++ks) { const bf16x8 a = *(const LAS bf16x8*)(lds + KDT + (16 * k + l15) * PT + (32 * ks + 8 * g) * 2), bb = *(const LAS bf16x8*)(lds + VT + (16 * wid + l15) * PT + (32 * ks + 8 * g) * 2);
                S[k] = mma16(a, bb, S[k]); } }
        __syncthreads();
        if (!STATS) {
#pragma unroll
            for (int cb = 0; cb < 4; ++cb)
#pragma unroll
                for (int ks = 0; ks < 2; ++ks) { const bf16x8 a = *(const LAS bf16x8*)(lds + ATT + (16 * cb + l15) * PT + (32 * ks + 8 * g) * 2), bb = *(const LAS bf16x8*)(lds + VT + (16 * wid + l15) * PT + (32 * ks + 8 * g) * 2);
                    ao[cb] = mma16(a, bb, ao[cb]); }
#pragma unroll
            for (int cb = 0; cb < 4; ++cb)
#pragma unroll
                for (int r = 0; r < 4; ++r) *(LAS float*)(lds + OO + (16 * cb + 4 * g + r) * PO + (16 * wid + l15) * 4) = ao[cb][r];
            __syncthreads();
            { const int row = tid >> 3, sg = tid & 7; const LAS f32x4* op = (const LAS f32x4*)(lds + OO + row * PO + sg * 64);
              f32x4 v[4]; float q = 0.f;
#pragma unroll
              for (int i = 0; i < 4; ++i) { v[i] = op[i]; q += (v[i][0] * v[i][0] + v[i][1] * v[i][1]) + (v[i][2] * v[i][2] + v[i][3] * v[i][3]); }
              q += __shfl_xor(q, 1); q += __shfl_xor(q, 2); q += __shfl_xor(q, 4);
              const float rstd = 1.f / sqrtf(q * (1.f / 128.f) + RMS_EPS);
              const size_t grow = (size_t)b * T_ + seg * 512 + ch * 64 + row;
              const bf16_t* gp = proj + grow * P0 + 3072 + h * 128 + sg * 16; const float* gn = P.in[11] + sg * 16;
              const u32x4 ga = *(const u32x4*)gp, gb = *(const u32x4*)(gp + 8);
              const unsigned gw[8] = {ga.x, ga.y, ga.z, ga.w, gb.x, gb.y, gb.z, gb.w};
              unsigned ow[8];
#pragma unroll
              for (int i = 0; i < 8; ++i) { const float x0 = v[i >> 1][(i & 1) * 2] * rstd * gn[2 * i] * __uint_as_float(gw[i] << 16), x1 = v[i >> 1][(i & 1) * 2 + 1] * rstd * gn[2 * i + 1] * __uint_as_float(gw[i] & 0xffff0000u);
                  ow[i] = cvt_pk_bf16(x0, x1); }
              bf16_t* mp = mix + grow * D_ + 512 + h * 128 + sg * 16;
              *(u32x4*)mp = (u32x4){ow[0], ow[1], ow[2], ow[3]}; *(u32x4*)(mp + 8) = (u32x4){ow[4], ow[5], ow[6], ow[7]}; }
            __syncthreads();
        }
    }
    if (STATS) {
        f32x4* sp = (f32x4*)(HGS + (size_t)u * 16384) + (wid * 8) * 64 + lane;
#pragma unroll
        for (int k = 0; k < 8; ++k) sp[k * 64] = S[k];
        if (qtr == 0) HGD[(size_t)u * 128 + col] = fexp(sumlog);
    }
}
template <bool STATS>
__device__ __forceinline__ void ph_hgrn(const Ptrs& P, LAS unsigned char* lds, int vcu, int G) {
    for (int u = vcu; u < 256; u += G) { hg_unit<STATS>(lds, P, u); __syncthreads(); }
}
}

namespace lru {
constexpr int XR = 0, XCB = 16896, WG = 35328;
constexpr int PX = 144;
constexpr size_t WS_HL = WS_P + 160 * MiB, WS_PL = WS_P + 192 * MiB, WS_ST2 = 488 * MiB;
__device__ __forceinline__ void lru_passA(LAS unsigned char* lds, const Ptrs& P, int u) {
    const int tid = threadIdx.x, lane = tid & 63, wid = __builtin_amdgcn_readfirstlane(tid >> 6), r32 = lane & 31, hi = lane >> 5;
    const int b = u >> 5, g = (u >> 2) & 7, q = u & 3;
    const bf16_t* proj = (const bf16_t*)(P.ws + WS_P);
    bf16_t* HL = (bf16_t*)(P.ws + WS_HL); bf16_t* PL = (bf16_t*)(P.ws + WS_PL); float* ST2 = (float*)(P.ws + WS_ST2);
    for (int idx = tid; idx < 8192; idx += 512) { const int k = idx >> 7, n = idx & 127;
        const float w = n < 64 ? P.in[16][(size_t)(g * 64 + k) * 64 + n] : P.in[18][(size_t)(g * 64 + k) * 64 + (n - 64)];
        *(LAS bf16_t*)(lds + WG + n * PX + k * 2) = f2bf(w); }
    const int ch = tid & 63, oct = tid >> 6, cg = g * 64 + ch;
    const float w0 = P.in[14][cg], w1 = P.in[14][512 + cg], w2 = P.in[14][1024 + cg], w3 = P.in[14][1536 + cg], cbv = P.in[15][cg];
    const int tb = wid >> 1, chh = wid & 1, chm = chh * 32 + r32, cgm = g * 64 + chm;
    const float bav = P.in[17][cgm], bxv = P.in[19][cgm], spv = softplusf_(-P.in[20][cgm]);
    __syncthreads();
    for (int sbk = 0; sbk < 8; ++sbk) {
        const int t0 = q * 1024 + sbk * 128;
        for (int idx = tid; idx < 131 * 8; idx += 512) { const int r = idx >> 3, c8 = idx & 7; const int t = t0 - 3 + r;
            u32x4 v = {0u, 0u, 0u, 0u}; if (t >= 0) v = *(const u32x4*)(proj + ((size_t)b * T_ + t) * P1 + g * 64 + c8 * 8);
            *(LAS u32x4*)(lds + XR + r * 128 + c8 * 16) = v; }
        __syncthreads();
#pragma unroll 4
        for (int i = 0; i < 16; ++i) { const int tl = oct * 16 + i; const LAS bf16_t* xp = (const LAS bf16_t*)(lds + XR) + tl * 64 + ch;
            const float xc = w0 * bf2f(xp[0]) + w1 * bf2f(xp[64]) + w2 * bf2f(xp[128]) + w3 * bf2f(xp[192]) + cbv;
            *(LAS bf16_t*)(lds + XCB + tl * PX + ch * 2) = f2bf(xc); }
        __syncthreads();
        f32x16 ga, gx;
#pragma unroll
        for (int r = 0; r < 16; ++r) { ga[r] = 0.f; gx[r] = 0.f; }
#pragma unroll
        for (int s = 0; s < 4; ++s) { const bf16x8 a = *(const LAS bf16x8*)(lds + XCB + (32 * tb + r32) * PX + (16 * s + 8 * hi) * 2);
            const bf16x8 ba_ = *(const LAS bf16x8*)(lds + WG + chm * PX + (16 * s + 8 * hi) * 2), bx_ = *(const LAS bf16x8*)(lds + WG + (64 + chm) * PX + (16 * s + 8 * hi) * 2);
            ga = __builtin_amdgcn_mfma_f32_32x32x16_bf16(a, ba_, ga, 0, 0, 0); gx = __builtin_amdgcn_mfma_f32_32x32x16_bf16(a, bx_, gx, 0, 0, 0); }
#pragma unroll
        for (int r = 0; r < 16; ++r) { const int t = 32 * tb + (r & 3) + 8 * (r >> 2) + 4 * hi;
            const float xcv = bf2f(*(const LAS bf16_t*)(lds + XCB + t * PX + chm * 2));
            const float rg = sigmoidf_(ga[r] + bav), ig = sigmoidf_(gx[r] + bxv);
            const float la = -8.f * rg * spv, a = fexp(la), x2 = 2.f * la;
            const float om = (x2 > -0.25f) ? -x2 * (1.f + 0.5f * x2 * (1.f + (1.f / 3.f) * x2 * (1.f + 0.25f * x2 * (1.f + 0.2f * x2)))) : 1.f - a * a;
            ga[r] = a; gx[r] = sqrtf(fmaxf(om, 1e-12f)) * (ig * xcv); }
        float Pg[4], Hg[4], Po[4], Ho[4];
#pragma unroll
        for (int gq = 0; gq < 4; ++gq) { float h = 0.f, pp = 1.f;
#pragma unroll
            for (int t = 0; t < 4; ++t) { h = ga[4 * gq + t] * h + gx[4 * gq + t]; pp *= ga[4 * gq + t]; gx[4 * gq + t] = h; ga[4 * gq + t] = pp; }
            Pg[gq] = pp; Hg[gq] = h; }
#pragma unroll
        for (int gq = 0; gq < 4; ++gq) { Po[gq] = swapother(Pg[gq], hi); Ho[gq] = swapother(Hg[gq], hi); }
        float c = 0.f, pp = 1.f, cin[4], pin[4];
#pragma unroll
        for (int gq = 0; gq < 4; ++gq) { const float P0 = hi ? Po[gq] : Pg[gq], H0 = hi ? Ho[gq] : Hg[gq], P1 = hi ? Pg[gq] : Po[gq], H1 = hi ? Hg[gq] : Ho[gq];
            const float cb0 = c, pb0 = pp; c = P0 * c + H0; pp *= P0; const float cb1 = c, pb1 = pp; c = P1 * c + H1; pp *= P1;
            cin[gq] = hi ? cb1 : cb0; pin[gq] = hi ? pb1 : pb0; }
        const size_t rowb = (size_t)b * T_ + t0 + 32 * tb;
#pragma unroll
        for (int r = 0; r < 16; ++r) { const float hl = gx[r] + ga[r] * cin[r >> 2], pc = ga[r] * pin[r >> 2]; const size_t off = (rowb + (r & 3) + 8 * (r >> 2) + 4 * hi) * 512 + cgm;
            HL[off] = f2bf(hl); PL[off] = f2bf(pc); }
        if (hi == 0) { float* sp = ST2 + ((size_t)(b * 128 + (t0 >> 5) + tb) * 512 + cgm) * 2; sp[0] = pp; sp[1] = c; }
        __syncthreads();
    }
}
__device__ __forceinline__ void lru_passB(const Ptrs& P, int u) {
    const int tid = threadIdx.x, ch = tid & 63, sl = tid >> 6;
    const int b = u >> 5, g = (u >> 2) & 7, q = u & 3, cg = g * 64 + ch;
    const bf16_t* proj = (const bf16_t*)(P.ws + WS_P); bf16_t* mix = (bf16_t*)(P.ws + WS_H);
    const bf16_t* HL = (const bf16_t*)(P.ws + WS_HL); const bf16_t* PL = (const bf16_t*)(P.ws + WS_PL); const float* ST2 = (const float*)(P.ws + WS_ST2);
    const int kb0 = q * 32 + sl * 4;
    const float* sp = ST2 + ((size_t)(b * 128) * 512 + cg) * 2;
    float c = 0.f;
    int k = 0;
    for (; k + 8 <= kb0; k += 8) { float pv[8], hv[8];
#pragma unroll
        for (int i = 0; i < 8; ++i) { pv[i] = sp[(size_t)(k + i) * 1024]; hv[i] = sp[(size_t)(k + i) * 1024 + 1]; }
#pragma unroll
        for (int i = 0; i < 8; ++i) c = pv[i] * c + hv[i]; }
    for (; k < kb0; ++k) c = sp[(size_t)k * 1024] * c + sp[(size_t)k * 1024 + 1];
    for (int kk = 0; kk < 4; ++kk) { const int kblk = kb0 + kk; const size_t rowb = (size_t)b * T_ + kblk * 32;
#pragma unroll 8
        for (int i = 0; i < 32; ++i) { const size_t row = rowb + i; const float hh = bf2f(HL[row * 512 + cg]) + bf2f(PL[row * 512 + cg]) * c;
            mix[row * D_ + cg] = f2bf(bf2f(proj[row * P1 + 512 + cg]) * hh); }
        c = sp[(size_t)kblk * 1024] * c + sp[(size_t)kblk * 1024 + 1]; }
}
template <bool STATS>
__device__ __forceinline__ void ph_lru(const Ptrs& P, LAS unsigned char* lds, int vcu, int G) {
    for (int u = vcu; u < 256; u += G) { if (STATS) lru_passA(lds, P, u); else lru_passB(P, u); }
}
}

#define XB_TMO      128
#define XB_XCNT(j)  (256  + 64 * (j))
#define XB_XSUB(j)  (1280 + 64 * (j))
#define XB_XGEN(j)  (2304 + 64 * (j))
#define XB_TOP      3328
#define XB_TOPGEN   3392
#define XCD_BAR_WORDS 3456
#define XB_SPIN_CAP (1u << 18)
__device__ __forceinline__ unsigned xb_ld(unsigned* p)              { return __hip_atomic_load(p, __ATOMIC_RELAXED, __HIP_MEMORY_SCOPE_AGENT); }
__device__ __forceinline__ unsigned xb_add(unsigned* p, unsigned v) { return __hip_atomic_fetch_add(p, v, __ATOMIC_RELAXED, __HIP_MEMORY_SCOPE_AGENT); }
__device__ __forceinline__ unsigned xb_xcc_id() { return (unsigned)__builtin_amdgcn_s_getreg((3 << 11) | 20) & 0xFu; }
#define XB_SPIN(cond, bar) do { unsigned _sp = 0; while (cond) { __builtin_amdgcn_s_sleep(1); \
    if ((++_sp & 255u) == 0u) { if (xb_ld(&(bar)[XB_TMO])) break; if (_sp > XB_SPIN_CAP) { atomicAdd(&(bar)[XB_TMO], 1u); break; } } } } while (0)
struct XcdBarrier { unsigned* bar; unsigned x; volatile LAS unsigned* st; };
__device__ __forceinline__ XcdBarrier xcd_barrier_post(unsigned* bar, volatile LAS unsigned* st) {
    XcdBarrier b; b.bar = bar; b.x = xb_xcc_id(); b.st = st;
    if (threadIdx.x == 0) (void)xb_add(&bar[XB_XCNT(b.x)], 1u);
    return b;
}
__device__ __forceinline__ void xcd_barrier_complete(unsigned* bar, unsigned x, unsigned& nloc, unsigned& nx) {
    const unsigned G = gridDim.x * gridDim.y * gridDim.z;
    unsigned sum, cnt, mine, sp = 0u;
    for (;;) {
        sum = 0u; cnt = 0u; mine = 0u;
#pragma unroll
        for (unsigned j = 0; j < 16; ++j) { const unsigned c = xb_ld(&bar[XB_XCNT(j)]); sum += c; cnt += (c > 0u) ? 1u : 0u; mine = (j == x) ? c : mine; }
        if (sum == G) break;
        __builtin_amdgcn_s_sleep(1);
        if ((++sp & 255u) == 0u) { if (xb_ld(&bar[XB_TMO])) break; if (sp > XB_SPIN_CAP) { atomicAdd(&bar[XB_TMO], 1u); break; } }
    }
    nloc = mine > 0u ? mine : 1u; nx = cnt > 0u ? cnt : 1u;
}
__device__ __forceinline__ void xcd_barrier(const XcdBarrier& b) {
    asm volatile("s_waitcnt vmcnt(0)" ::: "memory");
    __syncthreads();
    if (threadIdx.x == 0) {
        unsigned* bar = b.bar;
        __builtin_amdgcn_s_waitcnt(0);
        unsigned nloc = b.st[0], nx = b.st[1];
        if (nloc == 0u) { xcd_barrier_complete(bar, b.x, nloc, nx); b.st[0] = nloc; b.st[1] = nx; }
        const unsigned old = xb_add(&bar[XB_XSUB(b.x)], 1u);
        const unsigned gen = old / nloc;
        if (old + 1u == (gen + 1u) * nloc) {
            __builtin_amdgcn_fence(__ATOMIC_RELEASE, "agent");
            asm volatile("s_waitcnt vmcnt(0)" ::: "memory");
            const unsigned og = xb_add(&bar[XB_TOP], 1u);
            const unsigned tg = og / nx;
            if (og + 1u == (tg + 1u) * nx) xb_add(&bar[XB_TOPGEN], 1u);
            else XB_SPIN(xb_ld(&bar[XB_TOPGEN]) == tg, bar);
            __builtin_amdgcn_fence(__ATOMIC_ACQUIRE, "agent");
            xb_add(&bar[XB_XGEN(b.x)], 1u);
            asm volatile("s_waitcnt vmcnt(0)" ::: "memory");
        } else {
            XB_SPIN(xb_ld(&bar[XB_XGEN(b.x)]) == gen, bar);
            __builtin_amdgcn_fence(__ATOMIC_ACQUIRE, "agent");
            asm volatile("s_waitcnt vmcnt(0)" ::: "memory");
        }
    }
    __syncthreads();
}

struct Args { Ptrs p; int ph_lo, ph_hi; };
constexpr int LDS_BYTES = 147456;
constexpr int LDS_CTL = 131072;
__device__ __forceinline__ void moe_table(const Ptrs& P, int l, LAS unsigned char* lds) {
    LAS int* tab = (LAS int*)(lds + LDS_CTL);
    __syncthreads();
    if (threadIdx.x == 0) { const unsigned* gcnt = (const unsigned*)(P.ws + WS_CTL) + CW_GCNT + l * 16; int acc = 0;
        for (int e = 0; e < 16; ++e) { const int c = (int)__hip_atomic_load(gcnt + e, __ATOMIC_RELAXED, __HIP_MEMORY_SCOPE_AGENT); tab[e] = acc; tab[32 + e] = c; acc += (c + 255) >> 8; }
        tab[16] = acc; }
    __syncthreads();
}
#ifndef REP_DENSE
#define REP_DENSE 1
#endif
#ifndef REP_MOE
#define REP_MOE 1
#endif
#ifndef REP_DA
#define REP_DA 1
#endif
#ifndef REP_HG
#define REP_HG 1
#endif
#ifndef REP_LRU
#define REP_LRU 1
#endif
#ifndef REP_SB
#define REP_SB 1
#endif
#ifndef REP_PRO
#define REP_PRO 1
#endif
#define RUNREP(REP, ...) do { __VA_ARGS__; if (REP > 1) { xcd_barrier(bar); __VA_ARGS__; } } while (0)
template <int l>
__device__ __forceinline__ void layer_phases(const Args& a, LAS unsigned char* lds, int lo, int hi, int G, int bx, int vcu, const XcdBarrier& bar) {
#define IN(k) (lo <= (k) && (k) < hi)
#define BAR(k) do { if (lo <= (k) && (k) + 1 < hi) xcd_barrier(bar); } while (0)
    unsigned char* ws = a.p.ws;
    constexpr int pb = 2 + 8 * l;
    if (IN(pb + 0)) {
        constexpr int N = l == 0 ? P0 : P1;
        pg8::Gemm g{(const bf16_t*)(ws + WS_H), (const bf16_t*)(ws + (l == 0 ? WS_WINE : WS_WINO)), 1024, 0};
        pg8::StaticOrder S; S.init(M_, N, G, bx);
        constexpr unsigned long long modes = l == 0 ? (0x11ull | (0x22ull << 24) | (0x22ull << 48)) : ((0x33ull << 8) | (0x11ull << 16));
        pg8::EpiAct E{(bf16_t*)(ws + WS_P), N, modes, QSC};
        RUNREP(REP_DENSE, pg8::gemm_phase<pg8::EpiAct, pg8::StaticOrder, true, false>(lds, g, S, E));
    }
    BAR(pb + 0);
    if (IN(pb + 1)) { if constexpr (l == 0) { att::da_kmax(a.p, lds, vcu, G); RUNREP(REP_HG, hg::ph_hgrn<true>(a.p, lds, vcu, G)); } else RUNREP(REP_LRU, lru::ph_lru<true>(a.p, lds, vcu, G)); }
    BAR(pb + 1);
    if (IN(pb + 2)) { if constexpr (l == 0) { RUNREP(REP_HG, hg::ph_hgrn<false>(a.p, lds, vcu, G)); att::ph_diffattn(a.p, lds); }
                      else { RUNREP(REP_LRU, lru::ph_lru<false>(a.p, lds, vcu, G)); RUNREP(REP_SB, att::ph_sbattn(a.p, lds, vcu, G)); } }
    BAR(pb + 2);
    if (IN(pb + 3)) {
        pg8::Gemm g{(const bf16_t*)(ws + WS_H), (const bf16_t*)(ws + (l == 0 ? WS_WOUTE : WS_WOUTO)), 1024, 0};
        pg8::StaticOrder S; S.init(M_, 1024, G, bx);
        pg8::EpiAct E{(bf16_t*)(ws + WS_P), 1024, 0ull, 1.f};
        RUNREP(REP_DENSE, pg8::gemm_phase<pg8::EpiAct, pg8::StaticOrder, true, false>(lds, g, S, E));
    }
    BAR(pb + 3);
    if (IN(pb + 4)) ph_lnr(a.p, l, lds);
    BAR(pb + 4);
    if (IN(pb + 5)) {
        moe_table(a.p, l, lds);
        pg8::Gemm g{(const bf16_t*)(ws + WS_H), (const bf16_t*)(ws + WS_GU) + (size_t)l * 16 * 1024 * 1024, 1024, (size_t)1024 * 1024};
        pg8::MoeOrder S{(const LAS int*)(lds + LDS_CTL), (const int*)(ws + WS_LIST), G, vcu, 4};
        pg8::EpiGU E{(bf16_t*)(ws + WS_P)};
        RUNREP(REP_MOE, pg8::gemm_phase<pg8::EpiGU, pg8::MoeOrder, true, true>(lds, g, S, E));
    }
    BAR(pb + 5);
    if (IN(pb + 6)) {
        moe_table(a.p, l, lds);
        pg8::Gemm g{(const bf16_t*)(ws + WS_P), (const bf16_t*)(ws + WS_DN) + (size_t)l * 16 * 1024 * 512, 512, (size_t)1024 * 512};
        pg8::MoeOrder S{(const LAS int*)(lds + LDS_CTL), (const int*)(ws + WS_LIST), G, vcu, 4};
        pg8::EpiAct E{(bf16_t*)(ws + WS_YS), 1024, 0ull, 1.f};
        RUNREP(REP_MOE, pg8::gemm_phase<pg8::EpiAct, pg8::MoeOrder, true, false>(lds, g, S, E));
    }
    BAR(pb + 6);
    if (IN(pb + 7)) { if (OPT_MOE) ph_ln2<false>(a.p, l, lds); else ph_ln2<true>(a.p, l, lds); }
    BAR(pb + 7);
#undef IN
#undef BAR
}
__global__ void __launch_bounds__(512, 2) fwd(Args a) {
    extern __shared__ __attribute__((aligned(16))) unsigned char lds_raw[];
    LAS unsigned char* lds = (LAS unsigned char*)lds_raw;
    const int lo = a.ph_lo, hi = a.ph_hi;
    const int G = gridDim.x, bx = blockIdx.x; const int vcu = (G % 8 == 0) ? (bx % 8) * (G / 8) + bx / 8 : bx;
    if (threadIdx.x < 4) ((LAS unsigned*)(lds + LDS_CTL + 256))[threadIdx.x] = 0u;
    __syncthreads();
    const XcdBarrier bar = xcd_barrier_post((unsigned*)(a.p.ws + WS_CTL) + CW_BAR, (volatile LAS unsigned*)(lds + LDS_CTL + 256));
    if (lo <= 0 && 0 < hi) RUNREP(REP_PRO, ph_prologue(a.p, lds));
    if (lo <= 0 && 1 < hi) xcd_barrier(bar);
    if (lo <= 1 && 1 < hi) RUNREP(REP_PRO, ph_modulate(a.p));
    if (lo <= 1 && 2 < hi) xcd_barrier(bar);
    layer_phases<0>(a, lds, lo, hi, G, bx, vcu, bar);
    layer_phases<1>(a, lds, lo, hi, G, bx, vcu, bar);
}

extern "C" void kernel_launch(void* const* d_in, const int* in_sizes, int n_in, void* d_out, int out_size, void* d_ws, size_t ws_size, hipStream_t stream) {
    static int grid = 0;
    if (grid == 0) {
        if (n_in != 26 || out_size != M_ * D_ || ws_size < WS_END) { fprintf(stderr, "kernel_launch: unexpected shapes (n_in %d out %d ws %zu)\n", n_in, out_size, ws_size); grid = -1; return; }
        int dev = 0, cus = 0;
        hipGetDevice(&dev); hipDeviceGetAttribute(&cus, hipDeviceAttributeMultiprocessorCount, dev);
        hipFuncSetAttribute((const void*)fwd, hipFuncAttributeMaxDynamicSharedMemorySize, LDS_BYTES);
        grid = cus > 0 ? cus : 256;
    }
    if (grid < 0) return;
    hipMemsetAsync((char*)d_ws + WS_CTL, 0, CTL_BYTES, stream);
    Args a{};
    for (int i = 0; i < 26; ++i) a.p.in[i] = (const float*)d_in[i];
    a.p.out = (float*)d_out; a.p.ws = (unsigned char*)d_ws;
    unsigned char* ws = (unsigned char*)d_ws;
    auto run = [&](int k) { a.ph_lo = k; a.ph_hi = k + 1; hipLaunchKernelGGL(fwd, dim3(grid), dim3(512), LDS_BYTES, stream, a); };
    bf16_t* H = (bf16_t*)(ws + WS_H); bf16_t* PR = (bf16_t*)(ws + WS_P); bf16_t* YS = (bf16_t*)(ws + WS_YS);
    if (SINGLE_LAUNCH) { a.ph_lo = 0; a.ph_hi = 18; hipLaunchKernelGGL(fwd, dim3(grid), dim3(512), LDS_BYTES, stream, a); return; }
    run(0); run(1);
    for (int l = 0; l < 2; ++l) {
        const int pb = 2 + 8 * l;
        if (l == 0) {
            const unsigned long long modes = 0x11ull | (0x22ull << 24) | (0x22ull << 48);
            if (OPT_GEMM) run(pb + 0); else hipLaunchKernelGGL(ngemm, dim3(P0 / 64, M_ / 64), dim3(256), 0, stream, H, (const bf16_t*)(ws + WS_WINE), PR, P0, 1024, modes, QSC);
            if (OPT_HG) run(pb + 1);
            if (OPT_DA) run(pb + 2); else hipLaunchKernelGGL(nda, dim3(M_ * 4 / 4), dim3(256), 0, stream, PR, H, (const float*)d_in[8], (const float*)d_in[9]);
            if (!OPT_HG) hipLaunchKernelGGL(nhg, dim3(32), dim3(512), 0, stream, PR, H, (const float*)d_in[10], (const float*)d_in[11]);
            if (OPT_GEMM) run(pb + 3); else hipLaunchKernelGGL(ngemm, dim3(1024 / 64, M_ / 64), dim3(256), 0, stream, H, (const bf16_t*)(ws + WS_WOUTE), PR, 1024, 1024, 0ull, 1.f);
        } else {
            const unsigned long long modes = (0x33ull << 8) | (0x11ull << 16);
            if (OPT_GEMM) run(pb + 0); else hipLaunchKernelGGL(ngemm, dim3(P1 / 64, M_ / 64), dim3(256), 0, stream, H, (const bf16_t*)(ws + WS_WINO), PR, P1, 1024, modes, QSC);
            if (OPT_LRU) run(pb + 1); else hipLaunchKernelGGL(nlru, dim3(64), dim3(64), 0, stream, PR, H, (const float*)d_in[14], (const float*)d_in[15], (const float*)d_in[16], (const float*)d_in[17], (const float*)d_in[18], (const float*)d_in[19], (const float*)d_in[20]);
            if (OPT_SB) run(pb + 2); else hipLaunchKernelGGL(nsb, dim3(M_ * 8 / 4), dim3(256), 0, stream, PR, H);
            if (OPT_GEMM) run(pb + 3); else hipLaunchKernelGGL(ngemm, dim3(1024 / 64, M_ / 64), dim3(256), 0, stream, H, (const bf16_t*)(ws + WS_WOUTO), PR, 1024, 1024, 0ull, 1.f);
        }
        run(pb + 4);
        if (OPT_MOE) { run(pb + 5); run(pb + 6); } else hipLaunchKernelGGL(nmoe, dim3(M_), dim3(256), 0, stream, H, (const TokInfo*)(ws + WS_TOK), (const bf16_t*)(ws + WS_GU) + (size_t)l * 16 * 1024 * 1024, (const bf16_t*)(ws + WS_DN) + (size_t)l * 16 * 1024 * 512, YS);
        run(pb + 7);
    }
}
```
